# Optimizing an MI355X kernel written in HIP

```python
import jax, jax.numpy as jnp
from jax import lax
import numpy as np

D_MODEL = 1024
BATCH = 32
SEQ = 256
DEPTH = 2
DEC_BATCH = 2
DEC_SEQ = 1024
PAST_LEN = 512

GRID_W = 64
POS_BASE = 10000.0
EPS = 1e-6
HG_HEADS = 4
HG_DK = 128
HG_DV = 128
HG_WIDTH = HG_HEADS * HG_DV
HG_CHUNK = 16
SG_GROUPS = 4
SG_WIDTH = 512
SG_GROUP_DIM = SG_WIDTH // SG_GROUPS
SG_CHUNK = 128
POOL_WINDOWS = (2, 4, 8, 16)
POOL_WIDTH = 512
POOL_GROUP_DIM = POOL_WIDTH // len(POOL_WINDOWS)
N_BRANCH = 3
IN_COLS = 5 * HG_WIDTH + 2 * SG_WIDTH + POOL_WIDTH + N_BRANCH * D_MODEL
D_FF = 2816
CONV_WIDTH = 3
N_MOD = 6

kernel_name = "hybrid_hgrn2_sgmlp_pool_diffusion_step"


def rms_norm(x, gain):
    xf = x.astype(jnp.float32)
    y = xf * lax.rsqrt(jnp.mean(xf * xf, axis=-1, keepdims=True) + EPS)
    return (y * gain.astype(jnp.float32)).astype(x.dtype)


def grid_pos_embed(n_tokens, dtype):
    rows = n_tokens // GRID_W
    r = jnp.broadcast_to(jnp.arange(rows, dtype=jnp.float32)[:, None], (rows, GRID_W)).reshape(-1)
    col = jnp.broadcast_to(jnp.arange(GRID_W, dtype=jnp.float32)[None, :], (rows, GRID_W)).reshape(-1)
    quarter = D_MODEL // 4
    omega = 1.0 / (POS_BASE ** (jnp.arange(quarter, dtype=jnp.float32) / quarter))
    ar = r[:, None] * omega[None, :]
    ac = col[:, None] * omega[None, :]
    emb = jnp.concatenate([jnp.sin(ar), jnp.cos(ar), jnp.sin(ac), jnp.cos(ac)], axis=-1)
    return emb.astype(dtype)


def log_forget(z, lb):
    z = z.astype(jnp.float32)
    return jnp.logaddexp(0.0, jnp.log(lb) - z) - jax.nn.softplus(-z)


def gla_chunked(q, k, v, logf, s0):
    B, T, H, K = q.shape
    V = v.shape[-1]
    C = HG_CHUNK
    N = T // C
    q = q.reshape(B, N, C, H, K)
    k = k.reshape(B, N, C, H, K)
    v = v.reshape(B, N, C, H, V)
    b = jnp.cumsum(logf.reshape(B, N, C, H, K), axis=2)
    mask = jnp.tril(jnp.ones((C, C), dtype=bool))
    diff = b[:, :, :, None] - b[:, :, None, :]
    decay = jnp.exp(jnp.where(mask[None, None, :, :, None, None], diff, -jnp.inf))
    scores = jnp.einsum('bnthk,bnshk,bntshk->bnhts', q, k, decay)
    o_intra = jnp.einsum('bnhts,bnshv->bnthv', scores, v)
    b_last = b[:, :, -1]
    k_to_end = k * jnp.exp(b_last[:, :, None] - b)
    update = jnp.einsum('bnshk,bnshv->bnhkv', k_to_end, v)
    chunk_decay = jnp.exp(b_last)

    def step(s, inp):
        a_n, u_n = inp
        return a_n[..., None] * s + u_n, s

    s_fin, s_enter = lax.scan(step, s0.astype(jnp.float32),
                              (jnp.moveaxis(chunk_decay, 1, 0), jnp.moveaxis(update, 1, 0)))
    s_enter = jnp.moveaxis(s_enter, 0, 1)
    o_inter = jnp.einsum('bnthk,bnhkv->bnthv', q * jnp.exp(b), s_enter)
    return (o_intra + o_inter).reshape(B, T, H, V), s_fin


def hgrn2_mixer(zq, zf_fwd, zf_bwd, zi, zg, lb, norm_gain, s0):
    B, T, _ = zq.shape
    q = (jax.nn.silu(zq.astype(jnp.float32)) * HG_DK ** -0.5).reshape(B, T, HG_HEADS, HG_DK)
    v = zi.astype(jnp.float32).reshape(B, T, HG_HEADS, HG_DV)
    outs, finals = [], []
    for d, zf in enumerate((zf_fwd, zf_bwd)):
        logf = log_forget(zf, lb[d]).reshape(B, T, HG_HEADS, HG_DK)
        k = -jnp.expm1(logf)
        if d == 0:
            o, s_fin = gla_chunked(q, k, v, logf, s0[:, d])
        else:
            o, s_fin = gla_chunked(jnp.flip(q, axis=1), jnp.flip(k, axis=1), jnp.flip(v, axis=1),
                                   jnp.flip(logf, axis=1), s0[:, d])
            o = jnp.flip(o, axis=1)
        outs.append(o)
        finals.append(s_fin)
    gate = jax.nn.silu(zg.astype(jnp.float32)).reshape(B, T, HG_HEADS, HG_DV)
    o = rms_norm(outs[0] + outs[1], norm_gain) * gate
    return o.reshape(B, T, HG_WIDTH).astype(zq.dtype), jnp.stack(finals, axis=1)


def chunk_spatial_gating(zu, zv, v_gain, w_s, b_s):
    B, T, _ = zv.shape
    N = T // SG_CHUNK
    u = jax.nn.gelu(zu)
    v = rms_norm(jax.nn.gelu(zv), v_gain).reshape(B, N, SG_CHUNK, SG_GROUPS, SG_GROUP_DIM)
    mixed = jnp.einsum('gts,bnsgc->bntgc', w_s, v) + b_s.T[None, None, :, :, None]
    return u * mixed.reshape(B, T, SG_WIDTH).astype(u.dtype)


def multiscale_pool(zp, w_pool, scale):
    B, T, _ = zp.shape
    pf = zp.astype(jnp.float32)
    csum = jnp.concatenate([jnp.zeros((B, 1, POOL_WIDTH), jnp.float32), jnp.cumsum(pf, axis=1)], axis=1)
    t = jnp.arange(T)
    groups = []
    for gi, w in enumerate(POOL_WINDOWS):
        lo = jnp.clip(t - w // 2, 0, T)
        hi = jnp.clip(t + w // 2, 0, T)
        sl = slice(gi * POOL_GROUP_DIM, (gi + 1) * POOL_GROUP_DIM)
        cs = csum[..., sl]
        mean = (cs[:, hi] - cs[:, lo]) / (hi - lo).astype(jnp.float32)[None, :, None]
        groups.append(mean - pf[..., sl])
    pooled = jnp.stack(groups, axis=2)
    out = jnp.einsum('btgc,gcd->btgd', pooled, w_pool.astype(jnp.float32)).reshape(B, T, POOL_WIDTH)
    return (out * scale.astype(jnp.float32)).astype(zp.dtype)


def conv_ffn(x, w_up, conv_w, conv_b, w_down):
    h = x @ w_up
    hp = jnp.pad(h, ((0, 0), (1, 1), (0, 0)))
    h = hp[:, :-2] * conv_w[0] + hp[:, 1:-1] * conv_w[1] + hp[:, 2:] * conv_w[2] + conv_b
    a, b = jnp.split(h, 2, axis=-1)
    return (jax.nn.silu(a) * b) @ w_down


def trunk_layer(x, mod, s0, lb, p):
    shift1, scale1, gate1, shift2, scale2, gate2 = jnp.split(mod[:, None, :].astype(x.dtype), N_MOD, axis=-1)
    h = rms_norm(x, p['norm_mix']) * (1 + scale1) + shift1
    z = h @ p['w_in']
    widths = (HG_WIDTH,) * 5 + (SG_WIDTH,) * 2 + (POOL_WIDTH,)
    offsets = np.cumsum(widths).tolist()
    zq, zf_f, zf_b, zi, zg, zu, zv, zp, zgate = jnp.split(z, offsets, axis=-1)
    o_hg, s_fin = hgrn2_mixer(zq, zf_f, zf_b, zi, zg, lb, p['hg_norm'], s0)
    o_sg = chunk_spatial_gating(zu, zv, p['sg_norm'], p['sg_w'], p['sg_b'])
    o_pool = multiscale_pool(zp, p['pool_w'], p['pool_scale'])
    gates = jax.nn.sigmoid(zgate.astype(jnp.float32)).astype(x.dtype)
    g_hg, g_sg, g_pool = jnp.split(gates, N_BRANCH, axis=-1)
    merged = (g_hg * (o_hg @ p['w_branch_hg']) + g_sg * (o_sg @ p['w_branch_sg'])
              + g_pool * (o_pool @ p['w_branch_pool']))
    x = x + gate1 * (merged @ p['w_out'])
    h = rms_norm(x, p['norm_ffn']) * (1 + scale2) + shift2
    x = x + gate2 * conv_ffn(h, p['ffn_up'], p['ffn_conv_w'], p['ffn_conv_b'], p['ffn_down'])
    return x, s_fin


def setup_inputs(seed: int = 0) -> dict:
    key = jax.random.key(seed)
    ks = jax.random.split(key, 32)
    f32 = jnp.float32
    nrm = lambda k, shape, s: jax.random.normal(k, shape, f32) * s
    D = D_MODEL
    return {
        'x_prompt': nrm(ks[0], (BATCH, SEQ, D), 1.0),
        'x_sample': nrm(ks[1], (DEC_BATCH, DEC_SEQ, D), 1.0),
        'c': nrm(ks[2], (DEC_BATCH, D), 1.0),
        'state_hgrn': nrm(ks[3], (DEC_BATCH, DEPTH, 2, HG_HEADS, HG_DK, HG_DV), 0.5),
        'c_ctx': nrm(ks[4], (D,), 1.0),
        'norm_mix': 1.0 + nrm(ks[5], (DEPTH, D), 0.05),
        'norm_ffn': 1.0 + nrm(ks[6], (DEPTH, D), 0.05),
        'w_ada': nrm(ks[7], (DEPTH, D, N_MOD * D), 0.5 * D ** -0.5),
        'b_ada': nrm(ks[8], (DEPTH, N_MOD * D), 0.02),
        'w_in': nrm(ks[9], (DEPTH, D, IN_COLS), D ** -0.5),
        'lb_logits': nrm(ks[10], (DEPTH, 2, HG_WIDTH), 0.5),
        'hg_norm': 1.0 + nrm(ks[11], (DEPTH, HG_DV), 0.05),
        'w_branch_hg': nrm(ks[12], (DEPTH, HG_WIDTH, D), HG_WIDTH ** -0.5),
        'w_branch_sg': nrm(ks[13], (DEPTH, SG_WIDTH, D), SG_WIDTH ** -0.5),
        'w_branch_pool': nrm(ks[14], (DEPTH, POOL_WIDTH, D), POOL_WIDTH ** -0.5),
        'w_out': nrm(ks[15], (DEPTH, D, D), D ** -0.5),
        'sg_norm': 1.0 + nrm(ks[16], (DEPTH, SG_WIDTH), 0.05),
        'sg_w': nrm(ks[17], (DEPTH, SG_GROUPS, SG_CHUNK, SG_CHUNK), SG_CHUNK ** -0.5),
        'sg_b': 1.0 + nrm(ks[18], (DEPTH, SG_GROUPS, SG_CHUNK), 0.1),
        'pool_w': nrm(ks[19], (DEPTH, len(POOL_WINDOWS), POOL_GROUP_DIM, POOL_GROUP_DIM), POOL_GROUP_DIM ** -0.5),
        'pool_scale': 1.0 + nrm(ks[20], (DEPTH, POOL_WIDTH), 0.1),
        'ffn_up': nrm(ks[21], (DEPTH, D, 2 * D_FF), D ** -0.5),
        'ffn_conv_w': nrm(ks[22], (DEPTH, CONV_WIDTH, 2 * D_FF), CONV_WIDTH ** -0.5),
        'ffn_conv_b': nrm(ks[23], (DEPTH, 2 * D_FF), 0.02),
        'ffn_down': nrm(ks[24], (DEPTH, D_FF, D), D_FF ** -0.5),
        'final_norm': 1.0 + nrm(ks[25], (D,), 0.05),
    }


def reference(x_prompt, x_sample, c, state_hgrn, c_ctx, norm_mix, norm_ffn, w_ada, b_ada, w_in,
              lb_logits, hg_norm, w_branch_hg, w_branch_sg, w_branch_pool, w_out, sg_norm, sg_w, sg_b,
              pool_w, pool_scale, ffn_up, ffn_conv_w, ffn_conv_b, ffn_down, final_norm):
    lb_all = jnp.cumsum(jax.nn.softmax(lb_logits.astype(jnp.float32), axis=0), axis=0)
    lower = lb_all - lb_all[0]
    xp = x_prompt
    xs = x_sample + grid_pos_embed(x_sample.shape[1], x_sample.dtype)[None]
    n_ctx = x_prompt.shape[0]
    new_states = []
    for l in range(DEPTH):
        p = {'norm_mix': norm_mix[l], 'norm_ffn': norm_ffn[l], 'w_in': w_in[l], 'hg_norm': hg_norm[l],
             'w_branch_hg': w_branch_hg[l], 'w_branch_sg': w_branch_sg[l], 'w_branch_pool': w_branch_pool[l],
             'w_out': w_out[l], 'sg_norm': sg_norm[l], 'sg_w': sg_w[l], 'sg_b': sg_b[l],
             'pool_w': pool_w[l], 'pool_scale': pool_scale[l], 'ffn_up': ffn_up[l],
             'ffn_conv_w': ffn_conv_w[l], 'ffn_conv_b': ffn_conv_b[l], 'ffn_down': ffn_down[l]}
        mod_ctx = jax.nn.silu(c_ctx)[None, :] @ w_ada[l] + b_ada[l]
        mod_lat = jax.nn.silu(c) @ w_ada[l] + b_ada[l]
        s_zero = jnp.zeros((n_ctx, 2, HG_HEADS, HG_DK, HG_DV), jnp.float32)
        xp, s_ctx = trunk_layer(xp, mod_ctx, s_zero, lower[l], p)
        xs, _ = trunk_layer(xs, mod_lat, state_hgrn[:, l], lower[l], p)
        new_states.append(s_ctx)
    y_prompt = rms_norm(xp, final_norm)
    y_sample = rms_norm(xs, final_norm)
    new_state_hgrn = jnp.stack(new_states, axis=1).astype(x_prompt.dtype)
    return (y_prompt, y_sample, new_state_hgrn)
```

```cpp
#include <hip/hip_runtime.h>
#include <hip/hip_cooperative_groups.h>
#include <cstdio>
#include <cstdint>
namespace cg = cooperative_groups;

#ifndef MK_SPLIT
#define MK_SPLIT 0
#endif

#ifndef REPMASK
#define REPMASK 0
#endif
#ifndef PHSEL
#define PHSEL(x) true
#endif
#define LAS __attribute__((address_space(3)))
__device__ __forceinline__ int opaque_tid() { int t = (int)threadIdx.x; asm volatile("" : "+v"(t)); return t; }
#define TIDX opaque_tid()
typedef unsigned short bf16;
typedef float f32x4 __attribute__((ext_vector_type(4)));
typedef short bf16x8 __attribute__((ext_vector_type(8)));
typedef short s16x4 __attribute__((ext_vector_type(4)));
typedef unsigned u32x4 __attribute__((ext_vector_type(4)));
typedef unsigned u32x2 __attribute__((ext_vector_type(2)));

__device__ __forceinline__ float bf2f(unsigned v) { return __uint_as_float(v << 16); }
__device__ __forceinline__ float bflo(unsigned w) { return __uint_as_float(w << 16); }
__device__ __forceinline__ float bfhi(unsigned w) { return __uint_as_float(w & 0xffff0000u); }
__device__ __forceinline__ unsigned f2bf(float f) { unsigned u = __float_as_uint(f); return (u + 0x7fffu + ((u >> 16) & 1u)) >> 16; }
typedef float f32x2_t __attribute__((ext_vector_type(2))); typedef __bf16 bf16x2_t __attribute__((ext_vector_type(2)));
__device__ __forceinline__ unsigned pk2(float lo, float hi) { f32x2_t v = {lo, hi}; bf16x2_t b = __builtin_convertvector(v, bf16x2_t); return __builtin_bit_cast(unsigned, b); }
__device__ __forceinline__ float frcp(float x) { return __builtin_amdgcn_rcpf(x); }
__device__ __forceinline__ float sigm(float x) { return frcp(1.f + __expf(-x)); }
__device__ __forceinline__ float silu_f(float x) { return x * sigm(x); }
__device__ __forceinline__ float gelu_f(float x) { return x * sigm(1.5957691216057308f * (x + 0.044715f * x * x * x)); }
__device__ __forceinline__ float wave_sum(float v) {
#pragma unroll
    for (int o = 1; o < 64; o <<= 1) v += __shfl_xor(v, o);
    return v;
}

namespace pg8 {
#define PG8_LAS __attribute__((address_space(3)))
typedef unsigned short bf16_t;
constexpr int BM = 256, BK = 64, HALF = 128, HTB = HALF * BK * 2, STAGE_BYTES = 8 * HTB, NXCD = 8, WGM = 8;
__host__ __device__ __forceinline__ int lds_byte(int r, int c) { const int st = (r >> 4) * 2 + (c >> 5), rr = r & 15, cc = c & 31, ob = rr * 64 + cc * 2; return st * 1024 + (ob ^ (((ob >> 9) & 1) << 5)); }
__host__ __device__ __forceinline__ void stage_rc(int b, int& R, int& C) { const int st = b / 1024, sb = b % 1024, swz = sb ^ (((sb >> 9) & 1) << 5); R = (st >> 1) * 16 + swz / 64; C = (st & 1) * 32 + (swz % 64) / 2; }
__host__ __device__ __forceinline__ int perm32(int rho) { const int n = rho >> 4, i = rho & 15; return 8 * (i >> 2) + 4 * n + (i & 3); }
struct Unit { int pm, pn, k0, nt; };
struct Gemm { const bf16_t* A; const bf16_t* Bt; int M, N, K; };
struct StaticOrder {
    int nM, nN, nwg, G, c;
    __host__ __device__ void init(int M, int N, int G_, int c_) { nM = M / BM; nN = N / BM; nwg = nM * nN; G = G_; c = c_; }
    __host__ __device__ bool next(int i, Unit& u) const {
        const long L = (long)i * G + c; if (L >= nwg) return false;
        int wgid = (int)L; { const int q = nwg / NXCD, r = nwg % NXCD, xcd = wgid % NXCD, off = wgid / NXCD; wgid = (xcd < r ? xcd * (q + 1) : r * (q + 1) + (xcd - r) * q) + off; }
        const int nig = WGM * nN, gid = wgid / nig, fm = gid * WGM, gsz = (nM - fm) < WGM ? (nM - fm) : WGM;
        u.pm = fm + ((wgid % nig) % gsz); u.pn = (wgid % nig) / gsz; u.k0 = 0; u.nt = 0; return true;
    }
    __device__ __forceinline__ void a_ready(const Unit&) const {}
    __device__ __forceinline__ void done(const Unit&) const {}
};
struct TileOrder {
    int c, nch;
    __device__ bool next(int i, Unit& u) const {
        const int xcd = c & 7, slot = c >> 3; if (slot >= 20 || i >= nch) return false;
        const int L = xcd * 20 + slot; u.pm = i * 40 + (L >> 2); u.pn = i * 4 + (L & 3); u.k0 = 0; u.nt = 0; return true;
    }
    __device__ __forceinline__ void a_ready(const Unit&) const {}
    __device__ __forceinline__ void done(const Unit&) const {}
};
__device__ __forceinline__ unsigned cvt_pk_bf16(float lo, float hi) { return pk2(lo, hi); }

struct EpiStore {
    static constexpr bool PERM = true, AFTER_DRAIN = false;
    bf16_t* O; int ldc;
    __device__ __forceinline__ bool zero_after(const Unit&) const { return true; }
    __device__ __forceinline__ void operator()(f32x4 (&acc)[2][2][4][2], const Unit& u, int wr, int wc, int fr, int fq) const {
        const int row0 = u.pm * BM + wr * 64 + fr, col0 = u.pn * BM + wc * 32 + 8 * fq;
#pragma unroll
        for (int ai = 0; ai < 2; ++ai)
#pragma unroll
            for (int m = 0; m < 4; ++m) { bf16_t* rowp = O + (size_t)(row0 + ai * HALF + m * 16) * ldc + col0;
#pragma unroll
                for (int bj = 0; bj < 2; ++bj) { const f32x4 v0 = acc[ai][bj][m][0], v1 = acc[ai][bj][m][1];
                    u32x4 w; w.x = cvt_pk_bf16(v0[0], v0[1]); w.y = cvt_pk_bf16(v0[2], v0[3]); w.z = cvt_pk_bf16(v1[0], v1[1]); w.w = cvt_pk_bf16(v1[2], v1[3]);
                    *(u32x4*)(rowp + bj * HALF) = w; } }
    }
};
struct EpiZ {
    static constexpr bool PERM = true, AFTER_DRAIN = false;
    bf16_t* O; int ldc; int plain;
    __device__ __forceinline__ bool zero_after(const Unit&) const { return true; }
    __device__ __forceinline__ void operator()(f32x4 (&acc)[2][2][4][2], const Unit& u, int wr, int wc, int fr, int fq) const {
        const int row0 = u.pm * BM + wr * 64 + fr, col0 = u.pn * BM + wc * 32 + 8 * fq;
        const int pn = u.pn;
        const int mode = plain ? 0 : pn < 2 ? 1 : (pn < 8 ? 0 : (pn < 10 ? 2 : (pn < 14 ? 3 : (pn < 16 ? 0 : 4))));
#pragma unroll
        for (int ai = 0; ai < 2; ++ai)
#pragma unroll
            for (int m = 0; m < 4; ++m) { bf16_t* rowp = O + (size_t)(row0 + ai * HALF + m * 16) * ldc + col0;
#pragma unroll
                for (int bj = 0; bj < 2; ++bj) { float v[8];
#pragma unroll
                    for (int e = 0; e < 4; ++e) { v[e] = acc[ai][bj][m][0][e]; v[4 + e] = acc[ai][bj][m][1][e]; }
                    if (mode == 1) {
#pragma unroll
                        for (int e = 0; e < 8; ++e) v[e] = v[e] * sigm(v[e]) * 0.08838834764831845f;
                    } else if (mode == 2) {
#pragma unroll
                        for (int e = 0; e < 8; ++e) v[e] = v[e] * sigm(v[e]);
                    } else if (mode == 3) {
#pragma unroll
                        for (int e = 0; e < 8; ++e) v[e] = gelu_f(v[e]);
                    } else if (mode == 4) {
#pragma unroll
                        for (int e = 0; e < 8; ++e) v[e] = sigm(v[e]);
                    }
                    u32x4 w; w.x = cvt_pk_bf16(v[0], v[1]); w.y = cvt_pk_bf16(v[2], v[3]); w.z = cvt_pk_bf16(v[4], v[5]); w.w = cvt_pk_bf16(v[6], v[7]);
                    *(u32x4*)(rowp + bj * HALF) = w; } }
    }
};
struct EpiResid {
    static constexpr bool PERM = true, AFTER_DRAIN = false;
    float* X; const float* gate;
    __device__ __forceinline__ bool zero_after(const Unit&) const { return true; }
    __device__ __forceinline__ void operator()(f32x4 (&acc)[2][2][4][2], const Unit& u, int wr, int wc, int fr, int fq) const {
        const int modrow = u.pm < 32 ? 0 : 1 + ((u.pm - 32) >> 2);
        const int row0 = u.pm * BM + wr * 64 + fr, col0 = u.pn * BM + wc * 32 + 8 * fq;
        const float* g = gate + modrow * 6144 + col0;
        f32x4 gv[2][2];
#pragma unroll
        for (int bj = 0; bj < 2; ++bj) { gv[bj][0] = *(const f32x4*)(g + bj * HALF); gv[bj][1] = *(const f32x4*)(g + bj * HALF + 4); }
#pragma unroll
        for (int ai = 0; ai < 2; ++ai) {
            f32x4 xv[4][2][2];
#pragma unroll
            for (int m = 0; m < 4; ++m) { const float* rowp = X + (size_t)(row0 + ai * HALF + m * 16) * 1024 + col0;
#pragma unroll
                for (int bj = 0; bj < 2; ++bj) { xv[m][bj][0] = *(const f32x4*)(rowp + bj * HALF); xv[m][bj][1] = *(const f32x4*)(rowp + bj * HALF + 4); } }
#pragma unroll
            for (int m = 0; m < 4; ++m) { float* rowp = X + (size_t)(row0 + ai * HALF + m * 16) * 1024 + col0;
#pragma unroll
                for (int bj = 0; bj < 2; ++bj) {
                    *(f32x4*)(rowp + bj * HALF) = xv[m][bj][0] + gv[bj][0] * acc[ai][bj][m][0]; *(f32x4*)(rowp + bj * HALF + 4) = xv[m][bj][1] + gv[bj][1] * acc[ai][bj][m][1]; } }
            asm volatile("" ::: "memory"); }
    }
};
struct EpiBranch {
    static constexpr bool PERM = true, AFTER_DRAIN = false;
    const bf16_t* Z; bf16_t* O;
    __device__ __forceinline__ bool zero_after(const Unit& u) const { return u.pm >= 80; }
    __device__ __forceinline__ void operator()(f32x4 (&acc)[2][2][4][2], const Unit& u, int wr, int wc, int fr, int fq) const {
        const int br = u.pm / 40, pm = u.pm - br * 40, pn = u.pn - br * 4;
        const int row0 = pm * BM + wr * 64 + fr, col0 = pn * BM + wc * 32 + 8 * fq;
#pragma unroll
        for (int ai = 0; ai < 2; ++ai) {
            u32x4 gcv[4][2], gnv[4][2];
#pragma unroll
            for (int m = 0; m < 4; ++m)
#pragma unroll
                for (int bj = 0; bj < 2; ++bj) { const bf16_t* zq_ = Z + (size_t)(row0 + ai * HALF + m * 16) * 7168 + 4096 + br * 1024 + col0 + bj * HALF;
                    gcv[m][bj] = *(const u32x4*)zq_; gnv[m][bj] = br < 2 ? *(const u32x4*)(zq_ + 1024) : (u32x4){0u, 0u, 0u, 0u}; }
#pragma unroll
            for (int m = 0; m < 4; ++m) { const int row = row0 + ai * HALF + m * 16;
#pragma unroll
                for (int bj = 0; bj < 2; ++bj) {
                    const bf16_t* zp = Z + (size_t)row * 7168 + 4096 + br * 1024 + col0 + bj * HALF;
                    const u32x4 gc = gcv[m][bj];
                    float f[8];
                    if (br < 2) { const u32x4 gn = gnv[m][bj];
#pragma unroll
                        for (int e = 0; e < 4; ++e) { f[2 * e] = bflo(gc[e]) * frcp(fmaxf(bflo(gn[e]), 1e-20f)); f[2 * e + 1] = bfhi(gc[e]) * frcp(fmaxf(bfhi(gn[e]), 1e-20f)); }
                    } else {
#pragma unroll
                        for (int e = 0; e < 4; ++e) { f[2 * e] = bflo(gc[e]); f[2 * e + 1] = bfhi(gc[e]); }
                    }
                    f32x4 v0 = acc[ai][bj][m][0], v1 = acc[ai][bj][m][1];
                    v0[0] *= f[0]; v0[1] *= f[1]; v0[2] *= f[2]; v0[3] *= f[3]; v1[0] *= f[4]; v1[1] *= f[5]; v1[2] *= f[6]; v1[3] *= f[7];
                    if (br < 2) { acc[ai][bj][m][0] = v0; acc[ai][bj][m][1] = v1; }
                    else { u32x4 w; w.x = cvt_pk_bf16(v0[0], v0[1]); w.y = cvt_pk_bf16(v0[2], v0[3]); w.z = cvt_pk_bf16(v1[0], v1[1]); w.w = cvt_pk_bf16(v1[2], v1[3]);
                        *(u32x4*)(O + (size_t)row * 1024 + col0 + bj * HALF) = w; }
                } } }
    }
};

struct SplitOrder {
    int c, nt_own, nt_help;
    __device__ bool next(int i, Unit& u) const {
        const int xcd = c & 7, slot = c >> 3;
        if (slot < 20) { if (i) return false; const int L = xcd * 20 + slot; u.pm = L >> 2; u.pn = L & 3; u.k0 = 0; u.nt = nt_own; return true; }
        const int t = (slot - 20) * 8 + xcd + 96 * i; if (i >= 2 || t >= 160) return false;
        u.pm = t >> 2; u.pn = t & 3; u.k0 = nt_own; u.nt = nt_help; return true;
    }
    __device__ __forceinline__ void a_ready(const Unit&) const {}
    __device__ __forceinline__ void done(const Unit&) const {}
};
struct EpiResidSplit {
    static constexpr bool PERM = true, AFTER_DRAIN = true;
    EpiResid R; float* P; unsigned* flags; int c;
    __device__ __forceinline__ bool zero_after(const Unit&) const { return true; }
    __device__ __forceinline__ void operator()(f32x4 (&acc)[2][2][4][2], const Unit& u, int wr, int wc, int fr, int fq) const {
        if (u.k0 == 0) return;
        float* p = P + (size_t)(u.pm * 4 + u.pn) * 65536 + (((wr * 4 + wc) * 64 + fq * 16 + fr) << 2);
#pragma unroll
        for (int ai = 0; ai < 2; ++ai)
#pragma unroll
            for (int bj = 0; bj < 2; ++bj)
#pragma unroll
                for (int m = 0; m < 4; ++m)
#pragma unroll
                    for (int n = 0; n < 2; ++n) *(f32x4*)(p + ((((ai * 2 + bj) * 4 + m) * 2 + n) << 11)) = acc[ai][bj][m][n];
    }
    __device__ __forceinline__ void fused(f32x4 (&acc)[2][2][4][2], const Unit& u, int wr, int wc, int fr, int fq) const {
        const int tid = (wr * 4 + wc) * 64 + fq * 16 + fr;
        if (u.k0 != 0) {
            asm volatile("s_waitcnt vmcnt(0)" ::: "memory");
            __syncthreads();
            if (tid == 0) {
                __builtin_amdgcn_fence(__ATOMIC_RELEASE, "agent");
                asm volatile("s_waitcnt vmcnt(0)" ::: "memory");
                const int t0 = ((c >> 3) - 20) * 8 + (c & 7);
                __hip_atomic_store(flags + t0, 1u, __ATOMIC_RELAXED, __HIP_MEMORY_SCOPE_AGENT);
                if (t0 + 96 < 160) __hip_atomic_store(flags + t0 + 96, 1u, __ATOMIC_RELAXED, __HIP_MEMORY_SCOPE_AGENT);
            }
            return;
        }
        const int tile = u.pm * 4 + u.pn;
        if (tid == 0) { unsigned spins = 0;
            while (__hip_atomic_load(flags + tile, __ATOMIC_RELAXED, __HIP_MEMORY_SCOPE_AGENT) == 0u) { __builtin_amdgcn_s_sleep(1); if (++spins > (1u << 22)) break; }
            __builtin_amdgcn_fence(__ATOMIC_ACQUIRE, "agent");
            asm volatile("s_waitcnt vmcnt(0)" ::: "memory"); }
        __syncthreads();
        const float* p = P + (size_t)tile * 65536 + (tid << 2);
#pragma unroll
        for (int ai = 0; ai < 2; ++ai)
#pragma unroll
            for (int bj = 0; bj < 2; ++bj) { f32x4 t[4][2];
#pragma unroll
                for (int m = 0; m < 4; ++m)
#pragma unroll
                    for (int n = 0; n < 2; ++n) t[m][n] = *(const f32x4*)(p + ((((ai * 2 + bj) * 4 + m) * 2 + n) << 11));
#pragma unroll
                for (int m = 0; m < 4; ++m)
#pragma unroll
                    for (int n = 0; n < 2; ++n) acc[ai][bj][m][n] += t[m][n]; }
        R(acc, u, wr, wc, fr, fq);
    }
};

template <class Epi, class Sched, bool ALIGN_EPI = false, bool SP2 = false>
__device__ __forceinline__ void gemm_phase(PG8_LAS unsigned char* lds, const Gemm g, const Sched& S, const Epi& E) {
    const int tid = TIDX, wid = __builtin_amdgcn_readfirstlane(tid >> 6), lane = tid & 63, wr = wid >> 2, wc = wid & 3, fr = lane & 15, fq = lane >> 4;
    const int K = g.K, nt = K / BK;
    unsigned voffA[2], voffB[2];
#pragma unroll
    for (int i = 0; i < 2; ++i) { int R, C; stage_rc(tid * 16 + i * 8192, R, C); const int Rb = Epi::PERM ? ((R & ~31) + perm32(R & 31)) : R;
        voffA[i] = (unsigned)(R * K + C) * 2u; voffB[i] = (unsigned)(Rb * K + C) * 2u; }
    const size_t kstep = (size_t)(BK * 2);
    const size_t hstep = (size_t)HALF * K * 2;
    const size_t tstep = 2 * hstep;
    const unsigned ldsw = (unsigned)wid * 1024u;
    const int aoff = lds_byte(wr * 64 + fr, fq * 8), boff = lds_byte(wc * 32 + fr, fq * 8);
#define PG8_SA(b, h) (((b) * 2 + (h)) * HTB)
#define PG8_SB(b, h) ((4 + (b) * 2 + (h)) * HTB)
#define PG8_STAGE(bufoff, gbase, voff) do { _Pragma("unroll") for (int _i = 0; _i < 2; ++_i) \
        __builtin_amdgcn_global_load_lds((const unsigned*)((const char*)(gbase) + (voff)[_i]), (PG8_LAS unsigned*)(lds + (bufoff) + ldsw + _i * 8192), 16, 0, 0); } while (0)
#define PG8_LDA(dst, b, h) do { _Pragma("unroll") for (int m = 0; m < 4; ++m) _Pragma("unroll") for (int k = 0; k < 2; ++k) dst[m][k] = *(const PG8_LAS bf16x8*)(lds + PG8_SA(b, h) + aoff + m * 2048 + k * 1024); } while (0)
#define PG8_LDB(dst, b, h) do { _Pragma("unroll") for (int n = 0; n < 2; ++n) _Pragma("unroll") for (int k = 0; k < 2; ++k) dst[n][k] = *(const PG8_LAS bf16x8*)(lds + PG8_SB(b, h) + boff + n * 2048 + k * 1024); } while (0)
#define PG8_MMA(ai, bj, At, Bt) do { __builtin_amdgcn_s_setprio(1); _Pragma("unroll") for (int m = 0; m < 4; ++m) _Pragma("unroll") for (int n = 0; n < 2; ++n) _Pragma("unroll") for (int k = 0; k < 2; ++k) \
        acc[ai][bj][m][n] = __builtin_amdgcn_mfma_f32_16x16x32_bf16(Bt[n][k], At[m][k], acc[ai][bj][m][n], 0, 0, 0); __builtin_amdgcn_s_setprio(0); } while (0)
#define PG8_WAIT_V(n) asm volatile("s_waitcnt vmcnt(" #n ")" ::: "memory")
#define PG8_WAIT_L(n) asm volatile("s_waitcnt lgkmcnt(" #n ")" ::: "memory")
#define PG8_BAR __builtin_amdgcn_s_barrier()
#define PG8_SCHED __builtin_amdgcn_sched_barrier(0)
    Unit cur, nxt; int ui = 0;
    if (!S.next(0, cur)) return;
    f32x4 acc[2][2][4][2];
#pragma unroll
    for (int a = 0; a < 2; ++a)
#pragma unroll
        for (int b = 0; b < 2; ++b)
#pragma unroll
            for (int m = 0; m < 4; ++m)
#pragma unroll
                for (int n = 0; n < 2; ++n) acc[a][b][m][n] = (f32x4){0.f, 0.f, 0.f, 0.f};
    bf16x8 At[4][2], B0[2][2], B1[2][2];
    const char* cA = (const char*)g.A + (size_t)cur.pm * tstep + (size_t)cur.k0 * kstep; const char* cB = (const char*)g.Bt + (size_t)cur.pn * tstep + (size_t)cur.k0 * kstep;
    S.a_ready(cur);
    if constexpr (SP2) {
        PG8_STAGE(PG8_SB(0, 0), cB, voffB); PG8_STAGE(PG8_SB(0, 1), cB + hstep, voffB); PG8_STAGE(PG8_SA(0, 0), cA, voffA); PG8_STAGE(PG8_SA(0, 1), cA + hstep, voffA);
        if (wr == 1) PG8_BAR;
        PG8_WAIT_V(2); PG8_BAR;
        PG8_STAGE(PG8_SB(1, 0), cB + kstep, voffB); PG8_STAGE(PG8_SA(1, 0), cA + kstep, voffA); PG8_STAGE(PG8_SB(1, 1), cB + hstep + kstep, voffB);
        PG8_WAIT_V(6); PG8_BAR;
    } else {
        PG8_STAGE(PG8_SB(0, 0), cB, voffB); PG8_STAGE(PG8_SA(0, 0), cA, voffA); PG8_STAGE(PG8_SB(0, 1), cB + hstep, voffB); PG8_STAGE(PG8_SA(0, 1), cA + hstep, voffA);
        if (wr == 1) PG8_BAR;
        PG8_WAIT_V(4); PG8_BAR;
        PG8_STAGE(PG8_SB(1, 0), cB + kstep, voffB); PG8_STAGE(PG8_SA(1, 0), cA + kstep, voffA); PG8_STAGE(PG8_SB(1, 1), cB + hstep + kstep, voffB);
        PG8_WAIT_V(6); PG8_BAR;
    }
    for (;;) {
        const bool has_next = S.next(ui + 1, nxt);
        const char* nA = has_next ? (const char*)g.A + (size_t)nxt.pm * tstep + (size_t)nxt.k0 * kstep : cA; const char* nB = has_next ? (const char*)g.Bt + (size_t)nxt.pn * tstep + (size_t)nxt.k0 * kstep : cB;
        const int cnt = cur.nt ? cur.nt : nt;
        for (int t = 0; t < cnt; t += 2) {
            const bool last = (t == cnt - 2);
            const char* a1 = cA + (size_t)(t + 1) * kstep;
            const char* a2 = last ? nA : cA + (size_t)(t + 2) * kstep; const char* b2 = last ? nB : cB + (size_t)(t + 2) * kstep;
            const char* a3 = a2 + kstep; const char* b3 = b2 + kstep;
            if (last && has_next) S.a_ready(nxt);
            if constexpr (SP2) {
            PG8_LDB(B0, 0, 0); PG8_LDB(B1, 0, 1); PG8_SCHED; PG8_LDA(At, 0, 0); PG8_STAGE(PG8_SA(1, 1), a1 + hstep, voffA);
            PG8_WAIT_V(8); PG8_WAIT_L(0); PG8_BAR; PG8_MMA(0, 0, At, B0); PG8_MMA(0, 1, At, B1); PG8_BAR; PG8_SCHED;
            PG8_LDA(At, 0, 1); PG8_STAGE(PG8_SB(0, 0), b2, voffB); PG8_STAGE(PG8_SB(0, 1), b2 + hstep, voffB); PG8_STAGE(PG8_SA(0, 0), a2, voffA);
            PG8_WAIT_V(8); PG8_WAIT_L(0); PG8_BAR; PG8_MMA(1, 0, At, B0); PG8_MMA(1, 1, At, B1); PG8_BAR; PG8_SCHED;
            PG8_LDB(B0, 1, 0); PG8_LDB(B1, 1, 1); PG8_SCHED; PG8_LDA(At, 1, 0); PG8_STAGE(PG8_SA(0, 1), a2 + hstep, voffA);
            PG8_WAIT_V(8); PG8_WAIT_L(0); PG8_BAR; PG8_MMA(0, 0, At, B0); PG8_MMA(0, 1, At, B1); PG8_BAR; PG8_SCHED;
            PG8_LDA(At, 1, 1); PG8_STAGE(PG8_SB(1, 0), b3, voffB); PG8_STAGE(PG8_SB(1, 1), b3 + hstep, voffB); PG8_STAGE(PG8_SA(1, 0), a3, voffA);
            PG8_WAIT_V(8); PG8_WAIT_L(0); PG8_BAR; PG8_MMA(1, 0, At, B0); PG8_MMA(1, 1, At, B1); PG8_BAR; PG8_SCHED;
            } else {
            PG8_LDB(B0, 0, 0); PG8_SCHED; PG8_LDA(At, 0, 0); PG8_STAGE(PG8_SA(1, 1), a1 + hstep, voffA);
            PG8_WAIT_L(8); PG8_BAR; PG8_WAIT_L(0); PG8_MMA(0, 0, At, B0); PG8_BAR; PG8_SCHED;
            PG8_LDB(B1, 0, 1); PG8_STAGE(PG8_SB(0, 0), b2, voffB);
            PG8_BAR; PG8_WAIT_L(0); PG8_MMA(0, 1, At, B1); PG8_BAR;
            PG8_LDA(At, 0, 1); PG8_STAGE(PG8_SA(0, 0), a2, voffA);
            PG8_BAR; PG8_WAIT_L(0); PG8_MMA(1, 0, At, B0); PG8_BAR; PG8_SCHED;
            PG8_STAGE(PG8_SB(0, 1), b2 + hstep, voffB);
            PG8_WAIT_V(6); PG8_BAR; PG8_MMA(1, 1, At, B1); PG8_BAR;
            PG8_LDB(B0, 1, 0); PG8_SCHED; PG8_LDA(At, 1, 0); PG8_STAGE(PG8_SA(0, 1), a2 + hstep, voffA);
            PG8_WAIT_L(8); PG8_BAR; PG8_WAIT_L(0); PG8_MMA(0, 0, At, B0); PG8_BAR; PG8_SCHED;
            PG8_LDB(B1, 1, 1); PG8_STAGE(PG8_SB(1, 0), b3, voffB);
            PG8_BAR; PG8_WAIT_L(0); PG8_MMA(0, 1, At, B1); PG8_BAR;
            PG8_LDA(At, 1, 1); PG8_STAGE(PG8_SA(1, 0), a3, voffA);
            PG8_BAR; PG8_WAIT_L(0); PG8_MMA(1, 0, At, B0); PG8_BAR; PG8_SCHED;
            PG8_STAGE(PG8_SB(1, 1), b3 + hstep, voffB);
            PG8_WAIT_V(6); PG8_BAR; PG8_MMA(1, 1, At, B1); PG8_BAR;
            }
        }
        if constexpr (ALIGN_EPI) { if (wr == 0) PG8_BAR; }
        E(acc, cur, wr, wc, fr, fq);
        if (!has_next) break;
        if (E.zero_after(cur)) {
#pragma unroll
        for (int a = 0; a < 2; ++a)
#pragma unroll
            for (int b = 0; b < 2; ++b)
#pragma unroll
                for (int m = 0; m < 4; ++m)
#pragma unroll
                    for (int n = 0; n < 2; ++n) acc[a][b][m][n] = (f32x4){0.f, 0.f, 0.f, 0.f};
        }
        cur = nxt; cA = nA; cB = nB; ++ui;
        if constexpr (ALIGN_EPI) { if (wr == 1) PG8_BAR; }
    }
    PG8_WAIT_V(0);
    if constexpr (!ALIGN_EPI) { if (wr == 0) PG8_BAR; }
    PG8_BAR;
    if constexpr (Epi::AFTER_DRAIN) E.fused(acc, cur, wr, wc, fr, fq);

#undef PG8_SA
#undef PG8_SB
#undef PG8_STAGE
#undef PG8_LDA
#undef PG8_LDB
#undef PG8_MMA
#undef PG8_WAIT_V
#undef PG8_WAIT_L
#undef PG8_BAR
#undef PG8_SCHED
}
}

constexpr int D = 1024, MP = 8192, M = 10240, NZ = 7168, DFF = 2816, NUP = 5632, NMOD = 6144;
constexpr int ZQ = 0, ZFF = 512, ZI = 1536, ZG = 2048, ZU = 2560, ZV = 3072, ZP = 3584;
constexpr float EPS = 1e-6f;
constexpr size_t MiB = 1u << 20;
constexpr size_t WS_BAR = 512 * 1024, WS_MOD = 0, WS_WIN = 1 * MiB, WS_WBR = 15 * MiB, WS_WOUT = 18 * MiB, WS_WUP = 20 * MiB, WS_WDN = 31 * MiB, WS_H = 37 * MiB, WS_Z = 57 * MiB, WS_O3 = 197 * MiB, WS_END = 252 * MiB;
constexpr size_t WS_SL = WS_O3 + 30 * MiB, WS_QC = WS_O3 + 34 * MiB, WS_AS = WS_O3 + 38 * MiB;
constexpr int LDS_BYTES = 147456;
constexpr int NPHASE = 22;

struct Args {
    const float *x_prompt, *x_sample, *c, *state, *c_ctx, *norm_mix, *norm_ffn, *w_ada, *b_ada, *w_in, *lb_logits, *hg_norm, *w_br_hg, *w_br_sg, *w_br_pool, *w_out,
        *sg_norm, *sg_w, *sg_b, *pool_w, *pool_scale, *ffn_up, *conv_w, *conv_b, *ffn_down, *final_norm;
    float* out; unsigned char* ws; int ph_lo, ph_hi;
};

__device__ __forceinline__ void transpose_item(const float* W, int K, int N, bf16* WT, LAS float* scr, int item, int lane) {
    const int nblk = N / 32, kb = item / nblk, nb = item % nblk, k0 = 64 * kb, n0 = 32 * nb;
    float wv[32];
#pragma unroll
    for (int i = 0; i < 32; ++i) wv[i] = W[(size_t)(k0 + 2 * i + (lane >> 5)) * N + n0 + (lane & 31)];
#pragma unroll
    for (int i = 0; i < 32; ++i) scr[(2 * i + (lane >> 5)) * 33 + (lane & 31)] = wv[i];
    asm volatile("s_waitcnt lgkmcnt(0)" ::: "memory");
    const int c = lane & 7;
#pragma unroll
    for (int j = 0; j < 4; ++j) { const int n = (lane >> 3) + 8 * j; const LAS float* s = scr + (8 * c) * 33 + n;
        u32x4 o; o.x = pk2(s[0 * 33], s[1 * 33]); o.y = pk2(s[2 * 33], s[3 * 33]); o.z = pk2(s[4 * 33], s[5 * 33]); o.w = pk2(s[6 * 33], s[7 * 33]);
        *(u32x4*)(WT + (size_t)(n0 + n) * K + k0 + 8 * c) = o; }
    asm volatile("s_waitcnt lgkmcnt(0)" ::: "memory");
}
__device__ __forceinline__ void convert_set(const Args& a, LAS unsigned char* lds, int l, int mask, int wid, int nw) {
    const int lane = TIDX & 63, wave = TIDX >> 6;
    LAS float* scr = (LAS float*)(lds + wave * 16384);
    unsigned char* ws = a.ws;
    const int I_IN = (mask & 1) ? (D / 64) * (NZ / 32) : 0, I_B0 = (mask & 2) ? (512 / 64) * (D / 32) : 0, I_B1 = (mask & 4) ? (512 / 64) * (D / 32) : 0, I_B2 = (mask & 8) ? (512 / 64) * (D / 32) : 0;
    const int I_OUT = (mask & 16) ? (D / 64) * (D / 32) : 0, I_UP = (mask & 32) ? (D / 64) * (NUP / 32) : 0, I_DN = (mask & 64) ? (DFF / 64) * (D / 32) : 0;
    const int NITEMS = I_IN + I_B0 + I_B1 + I_B2 + I_OUT + I_UP + I_DN;
    for (int it = wid; it < NITEMS; it += nw) {
        int r = it;
        if (r < I_IN) { transpose_item(a.w_in + (size_t)l * D * NZ, D, NZ, (bf16*)(ws + WS_WIN), scr, r, lane); continue; } r -= I_IN;
        if (r < I_B0) { transpose_item(a.w_br_hg + (size_t)l * 512 * D, 512, D, (bf16*)(ws + WS_WBR), scr, r, lane); continue; } r -= I_B0;
        if (r < I_B1) { transpose_item(a.w_br_sg + (size_t)l * 512 * D, 512, D, (bf16*)(ws + WS_WBR) + 1024 * 512, scr, r, lane); continue; } r -= I_B1;
        if (r < I_B2) { transpose_item(a.w_br_pool + (size_t)l * 512 * D, 512, D, (bf16*)(ws + WS_WBR) + 2 * 1024 * 512, scr, r, lane); continue; } r -= I_B2;
        if (r < I_OUT) { transpose_item(a.w_out + (size_t)l * D * D, D, D, (bf16*)(ws + WS_WOUT), scr, r, lane); continue; } r -= I_OUT;
        if (r < I_UP) { transpose_item(a.ffn_up + (size_t)l * D * NUP, D, NUP, (bf16*)(ws + WS_WUP), scr, r, lane); continue; } r -= I_UP;
        transpose_item(a.ffn_down + (size_t)l * DFF * D, DFF, D, (bf16*)(ws + WS_WDN), scr, r, lane);
    }
}
__device__ __forceinline__ void phase_mods(const Args& a, LAS unsigned char* lds) {
    const int tid = TIDX;
    LAS float* sc = (LAS float*)lds;
    LAS float* red = (LAS float*)(lds + 12288);
    float* mods = (float*)(a.ws + WS_MOD);
    for (int blk = blockIdx.x; blk < 256; blk += gridDim.x) {
        const int l = blk >> 7, n0 = (blk & 127) * 48;
        for (int i = tid; i < 3072; i += 512) { const int r = i >> 10, k = i & 1023; const float v = r == 0 ? a.c_ctx[k] : a.c[(r - 1) * 1024 + k]; sc[i] = silu_f(v); }
        __syncthreads();
        const int ks = tid / 12, c4 = tid - ks * 12;
        if (ks < 42) {
            const float* W = a.w_ada + (size_t)l * D * NMOD + n0 + 4 * c4;
            f32x4 a0 = (f32x4){0.f, 0.f, 0.f, 0.f}, a1 = a0, a2 = a0;
#pragma unroll 5
            for (int k = ks; k < 1024; k += 42) { const f32x4 wv = *(const f32x4*)(W + (size_t)k * NMOD); a0 += wv * sc[k]; a1 += wv * sc[1024 + k]; a2 += wv * sc[2048 + k]; }
            *(LAS f32x4*)(red + (ks * 3 + 0) * 48 + 4 * c4) = a0; *(LAS f32x4*)(red + (ks * 3 + 1) * 48 + 4 * c4) = a1; *(LAS f32x4*)(red + (ks * 3 + 2) * 48 + 4 * c4) = a2;
        }
        __syncthreads();
        if (tid < 144) { const int r = tid / 48, cc = tid - r * 48; float sm = 0.f;
            for (int w = 0; w < 42; ++w) sm += red[(w * 3 + r) * 48 + cc];
            mods[(l * 3 + r) * NMOD + n0 + cc] = sm + a.b_ada[l * NMOD + n0 + cc]; }
        __syncthreads();
    }
}
__device__ __forceinline__ void phase_norm(const Args& a, int l, const float* gain, int shift_off, bool first) {
    const int lane = TIDX & 63, wave = TIDX >> 6;
    const int gw = blockIdx.x * 8 + wave, NGW = gridDim.x * 8;
    const float* mods = (const float*)(a.ws + WS_MOD) + (size_t)l * 3 * NMOD;
    bf16* H = (bf16*)(a.ws + WS_H);
    f32x4 gn[4];
#pragma unroll
    for (int j = 0; j < 4; ++j) gn[j] = *(const f32x4*)(gain + 4 * (lane + 64 * j));
    for (int row = gw; row < M; row += NGW) {
        const int modrow = row < MP ? 0 : 1 + ((row - MP) >> 10);
        const float* src = first ? (row < MP ? a.x_prompt + (size_t)row * D : a.x_sample + (size_t)(row - MP) * D) : a.out + (size_t)row * D;
        f32x4 v[4]; float s = 0.f;
#pragma unroll
        for (int j = 0; j < 4; ++j) v[j] = *(const f32x4*)(src + 4 * (lane + 64 * j));
        if (first) {
            if (row >= MP) {
                const int n = (row - MP) & 1023; const float pr = (float)(n >> 6), pc = (float)(n & 63);
#pragma unroll
                for (int e = 0; e < 4; ++e) { const float om = expf(-(float)(4 * lane + e) * (9.210340371976184f / 256.f));
                    v[0][e] += sinf(pr * om); v[1][e] += cosf(pr * om); v[2][e] += sinf(pc * om); v[3][e] += cosf(pc * om); }
            }
#pragma unroll
            for (int j = 0; j < 4; ++j) *(f32x4*)(a.out + (size_t)row * D + 4 * (lane + 64 * j)) = v[j];
        }
#pragma unroll
        for (int j = 0; j < 4; ++j) s += (v[j][0] * v[j][0] + v[j][1] * v[j][1]) + (v[j][2] * v[j][2] + v[j][3] * v[j][3]);
        const float rstd = rsqrtf(wave_sum(s) * (1.f / D) + EPS);
        const float* mr = mods + modrow * NMOD + shift_off;
#pragma unroll
        for (int j = 0; j < 4; ++j) { const int c0 = 4 * (lane + 64 * j);
            const f32x4 sh = *(const f32x4*)(mr + c0), scl = *(const f32x4*)(mr + 1024 + c0);
            const f32x4 y = v[j] * rstd * gn[j] * (scl + 1.f) + sh;
            u32x2 o; o.x = pk2(y[0], y[1]); o.y = pk2(y[2], y[3]);
            *(u32x2*)(H + (size_t)row * D + c0) = o; }
    }
}
__device__ __forceinline__ void phase_final(const Args& a) {
    const int lane = TIDX & 63, wave = TIDX >> 6;
    const int gw = blockIdx.x * 8 + wave, NGW = gridDim.x * 8;
    f32x4 gn[4];
#pragma unroll
    for (int j = 0; j < 4; ++j) gn[j] = *(const f32x4*)(a.final_norm + 4 * (lane + 64 * j));
    for (int row = gw; row < M; row += NGW) {
        float* xr = a.out + (size_t)row * D;
        f32x4 v[4]; float s = 0.f;
#pragma unroll
        for (int j = 0; j < 4; ++j) { v[j] = *(const f32x4*)(xr + 4 * (lane + 64 * j)); s += (v[j][0] * v[j][0] + v[j][1] * v[j][1]) + (v[j][2] * v[j][2] + v[j][3] * v[j][3]); }
        const float rstd = rsqrtf(wave_sum(s) * (1.f / D) + EPS);
#pragma unroll
        for (int j = 0; j < 4; ++j) *(f32x4*)(xr + 4 * (lane + 64 * j)) = v[j] * rstd * gn[j];
    }
}

constexpr int SC_QT = 0, SC_KT = 4352, SC_QD = 8704, SC_KE = 13056, SC_VT = 18176, SC_AD = 23296, SC_BUF = 23808, SC_TOT = 2 * SC_BUF;
__device__ __forceinline__ s16x4 pack4(f32x4 v) { u32x2 p; p.x = pk2(v[0], v[1]); p.y = pk2(v[2], v[3]); return __builtin_bit_cast(s16x4, p); }
__device__ __forceinline__ void scan_item(const Args& a, LAS unsigned char* lds, int l, int s, int h, int d, int seg) {
    const int tid = TIDX, lane = tid & 63, w = tid >> 6, fr = lane & 15, fq = lane >> 4;
    const int k = (w & 1) * 64 + lane, tg = w >> 1;
    const int T = s < 32 ? 256 : 1024, base = s < 32 ? s * 256 : MP + (s - 32) * 1024, nch = 16, pos0 = 256 * seg;
    const bf16* Z = (const bf16*)(a.ws + WS_Z);
    bf16* OH = (bf16*)(a.ws + WS_H) + (size_t)d * M * 512;
    const int sidx = (((s - 32) * 4 + h) * 2 + d) * 4 + seg;
    bf16* QC = (bf16*)(a.ws + WS_QC) + (size_t)((((s - 32) * 4 + h) * 2 + d) * 1024) * 128;
    float run = 1.f;
    float lb = 0.f;
    if (l == 1) lb = sigm(a.lb_logits[(2 + d) * 512 + h * 128 + k] - a.lb_logits[d * 512 + h * 128 + k]);
    const float oml = 1.f - lb;
    f32x4 S[8];
    if (s >= 32 && seg == 0) { const float* st = a.state + ((((size_t)(s - 32) * 2 + l) * 2 + d) * 4 + h) * 16384;
#pragma unroll
        for (int r = 0; r < 8; ++r)
#pragma unroll
            for (int i = 0; i < 4; ++i) S[r][i] = st[(16 * r + 4 * fq + i) * 128 + 16 * w + fr];
    } else {
#pragma unroll
        for (int r = 0; r < 8; ++r) S[r] = (f32x4){0.f, 0.f, 0.f, 0.f};
    }
    LAS float* TOT = (LAS float*)(lds + SC_TOT);
    const int zcol_q = ZQ + h * 128 + k, zcol_f = ZFF + d * 512 + h * 128 + k, zcol_i = ZI + h * 128 + k;
    unsigned short nq[4], nf[4], ni[4];
#define SC_TOK(c, j) (d == 0 ? pos0 + 16 * (c) + (j) : T - 1 - pos0 - 16 * (c) - (j))
#define SC_ROW(c, j) (base + SC_TOK(c, j))
#define SC_BAR() do { asm volatile("s_waitcnt lgkmcnt(0)" ::: "memory"); __builtin_amdgcn_s_barrier(); asm volatile("" ::: "memory"); } while (0)
#pragma unroll
    for (int e = 0; e < 4; ++e) { const size_t ro = (size_t)SC_ROW(0, 4 * tg + e) * NZ; nq[e] = Z[ro + zcol_q]; nf[e] = Z[ro + zcol_f]; ni[e] = Z[ro + zcol_i]; }
    {
      for (int c = 0; c < nch; ++c) {
        float q[4], kk[4], pf[4], vv[4];
#pragma unroll
        for (int e = 0; e < 4; ++e) {
            const float zf = fmaxf(bf2f(nf[e]), -30.f), ex = __expf(-zf), sg = frcp(1.f + ex);
            pf[e] = lb + oml * sg; kk[e] = oml * ex * sg; q[e] = bf2f(nq[e]); vv[e] = bf2f(ni[e]);
        }
        if (c + 1 < nch) {
#pragma unroll
            for (int e = 0; e < 4; ++e) { const size_t ro = (size_t)SC_ROW(c + 1, 4 * tg + e) * NZ; nq[e] = Z[ro + zcol_q]; nf[e] = Z[ro + zcol_f]; ni[e] = Z[ro + zcol_i]; }
        }
        pf[1] *= pf[0]; pf[2] *= pf[1]; pf[3] *= pf[2];
        TOT[tg * 128 + k] = pf[3];
        SC_BAR();
        const float t0 = TOT[k], t1 = TOT[128 + k], t2 = TOT[256 + k], t3 = TOT[384 + k];
        const float off = (tg > 0 ? t0 : 1.f) * (tg > 1 ? t1 : 1.f) * (tg > 2 ? t2 : 1.f), pref = t0 * t1, p15 = pref * (t2 * t3);
        const float ipref = frcp(fmaxf(pref, 1e-30f));
        LAS unsigned char* B = lds + (c & 1) * SC_BUF;
        float ke[4];
#pragma unroll
        for (int e = 0; e < 4; ++e) { const float P = off * pf[e], iP = frcp(fmaxf(P, 1e-30f)); const int j = 4 * tg + e;
            const unsigned w0 = pk2(q[e] * (P * ipref), kk[e] * (pref * iP)), w1 = pk2(q[e] * P, 0.f);
            ((LAS bf16*)(B + SC_QT))[j * 136 + k] = (bf16)(w0 & 0xffffu);
            ((LAS bf16*)(B + SC_KT))[j * 136 + k] = (bf16)(w0 >> 16);
            ((LAS bf16*)(B + SC_QD))[j * 136 + k] = (bf16)(w1 & 0xffffu);
            if (s >= 32) QC[(size_t)SC_TOK(c, j) * 128 + k] = (bf16)(pk2(q[e] * P * run, 0.f) & 0xffffu);
            ke[e] = kk[e] * (p15 * iP); }
        run *= p15;
        { u32x2 p; p.x = pk2(ke[0], ke[1]); p.y = pk2(ke[2], ke[3]); *(LAS u32x2*)(B + SC_KE + k * 40 + tg * 8) = p;
          p.x = pk2(vv[0], vv[1]); p.y = pk2(vv[2], vv[3]); *(LAS u32x2*)(B + SC_VT + k * 40 + tg * 8) = p; }
        if (tg == 0) ((LAS float*)(B + SC_AD))[k] = p15;
        SC_BAR();
        f32x4 pt = (f32x4){0.f, 0.f, 0.f, 0.f};
#pragma unroll
        for (int k4 = 0; k4 < 4; ++k4) {
            const bf16x8 ka = *(const LAS bf16x8*)(B + SC_KT + fr * 272 + k4 * 64 + fq * 16);
            const bf16x8 qb = *(const LAS bf16x8*)(B + SC_QT + fr * 272 + k4 * 64 + fq * 16);
            pt = __builtin_amdgcn_mfma_f32_16x16x32_bf16(ka, qb, pt, 0, 0, 0);
        }
#pragma unroll
        for (int i = 0; i < 4; ++i) if (4 * fq + i > fr) pt[i] = 0.f;
        const s16x4 pa = pack4(pt);
        const s16x4 vb = *(const LAS s16x4*)(B + SC_VT + (16 * w + fr) * 40 + fq * 8);
        f32x4 o = __builtin_amdgcn_mfma_f32_16x16x16bf16_1k(pa, vb, (f32x4){0.f, 0.f, 0.f, 0.f}, 0, 0, 0);
#pragma unroll
        for (int r = 0; r < 8; ++r) {
            const s16x4 qa = *(const LAS s16x4*)(B + SC_QD + fr * 272 + r * 32 + fq * 8);
            o = __builtin_amdgcn_mfma_f32_16x16x16bf16_1k(qa, pack4(S[r]), o, 0, 0, 0);
        }
#pragma unroll
        for (int r = 0; r < 8; ++r) {
            const f32x4 ad = *(const LAS f32x4*)(B + SC_AD + (16 * r + 4 * fq) * 4);
            const s16x4 ka = *(const LAS s16x4*)(B + SC_KE + (16 * r + fr) * 40 + fq * 8);
            S[r] = __builtin_amdgcn_mfma_f32_16x16x16bf16_1k(ka, vb, S[r] * ad, 0, 0, 0);
        }
#pragma unroll
        for (int i = 0; i < 4; ++i) OH[(size_t)SC_ROW(c, 4 * fq + i) * 512 + h * 128 + 16 * w + fr] = (bf16)(pk2(o[i], 0.f) & 0xffffu);
      }
    }
#undef SC_ROW
#undef SC_TOK
#undef SC_BAR
    if (s >= 32) { float* sl = (float*)(a.ws + WS_SL) + (size_t)sidx * 16384;
#pragma unroll
        for (int r = 0; r < 8; ++r)
#pragma unroll
            for (int i = 0; i < 4; ++i) sl[(16 * r + 4 * fq + i) * 128 + 16 * w + fr] = S[r][i];
        if (tg == 0) ((float*)(a.ws + WS_AS))[sidx * 128 + k] = run; }
    if (s < 32) { float* st = a.out + (size_t)M * D + ((((size_t)s * 2 + l) * 2 + d) * 4 + h) * 16384;
#pragma unroll
        for (int r = 0; r < 8; ++r)
#pragma unroll
            for (int i = 0; i < 4; ++i) st[(16 * r + 4 * fq + i) * 128 + 16 * w + fr] = S[r][i]; }
    __syncthreads();
}
__device__ __forceinline__ void mm128(const LAS bf16* As, const LAS bf16* Bs, f32x4 (&acc)[2][4], int wr, int wc, int fr, int fq, bool zero = true) {
    if (zero) {
#pragma unroll
    for (int mt = 0; mt < 2; ++mt)
#pragma unroll
        for (int nt = 0; nt < 4; ++nt) acc[mt][nt] = (f32x4){0.f, 0.f, 0.f, 0.f}; }
#pragma unroll
    for (int k4 = 0; k4 < 4; ++k4) {
        bf16x8 af[2];
#pragma unroll
        for (int mt = 0; mt < 2; ++mt) af[mt] = *(const LAS bf16x8*)(As + (32 * wr + 16 * mt + fr) * 136 + 32 * k4 + 8 * fq);
#pragma unroll
        for (int nt = 0; nt < 4; ++nt) {
            const bf16x8 bfr = *(const LAS bf16x8*)(Bs + (64 * wc + 16 * nt + fr) * 136 + 32 * k4 + 8 * fq);
#pragma unroll
            for (int mt = 0; mt < 2; ++mt) acc[mt][nt] = __builtin_amdgcn_mfma_f32_16x16x32_bf16(af[mt], bfr, acc[mt][nt], 0, 0, 0);
        }
    }
}
__device__ __forceinline__ void stage_f32_tile(const float* W, LAS bf16* T) {
#pragma unroll
    for (int it = 0; it < 8; ++it) { const int idx = TIDX * 4 + 2048 * it, r = idx >> 7, cc = idx & 127;
        const f32x4 v = *(const f32x4*)(W + idx); u32x2 o; o.x = pk2(v[0], v[1]); o.y = pk2(v[2], v[3]); *(LAS u32x2*)(T + r * 136 + cc) = o; }
}
__device__ __forceinline__ void stage_f32_tile_T(const float* W, LAS bf16* T) {
#pragma unroll
    for (int it = 0; it < 4; ++it) { const int p = TIDX + 512 * it, n = p & 127, k0 = (p >> 7) * 8;
        float v[8];
#pragma unroll
        for (int e = 0; e < 8; ++e) v[e] = W[(size_t)(k0 + e) * 128 + n];
        u32x4 o; o.x = pk2(v[0], v[1]); o.y = pk2(v[2], v[3]); o.z = pk2(v[4], v[5]); o.w = pk2(v[6], v[7]);
        *(LAS u32x4*)(T + n * 136 + k0) = o; }
}
__device__ __forceinline__ void sg_item(const Args& a, LAS unsigned char* lds, int l, int ci) {
    const int tid = TIDX, lane = tid & 63, w = tid >> 6, fr = lane & 15, fq = lane >> 4, wr = w >> 1, wc = w & 1;
    const int r0 = ci * 128;
    const bf16* Z = (const bf16*)(a.ws + WS_Z);
    bf16* O = (bf16*)(a.ws + WS_O3) + (size_t)M * 512;
    LAS bf16* As = (LAS bf16*)lds; LAS bf16* Bs = (LAS bf16*)(lds + 34816); LAS float* rstd = (LAS float*)(lds + 69632);
    { u32x4 zz[16];
#pragma unroll
      for (int rr = 0; rr < 16; ++rr) zz[rr] = *(const u32x4*)(Z + (size_t)(r0 + 16 * w + rr) * NZ + ZV + 8 * lane);
#pragma unroll
      for (int rr = 0; rr < 16; ++rr) { float ss = 0.f;
#pragma unroll
        for (int e = 0; e < 4; ++e) { const float g0 = bflo(zz[rr][e]), g1 = bfhi(zz[rr][e]); ss += g0 * g0 + g1 * g1; }
        ss = wave_sum(ss); if (lane == 0) rstd[16 * w + rr] = rsqrtf(ss * (1.f / 512.f) + EPS); } }
    __syncthreads();
    for (int g = 0; g < 4; ++g) {
        stage_f32_tile(a.sg_w + ((size_t)l * 4 + g) * 16384, As);
#pragma unroll
        for (int it = 0; it < 4; ++it) { const int p = tid + 512 * it, c = p & 127, s0 = (p >> 7) * 8;
            const float gn = a.sg_norm[l * 512 + g * 128 + c];
            float v[8];
#pragma unroll
            for (int e = 0; e < 8; ++e) v[e] = bf2f(Z[(size_t)(r0 + s0 + e) * NZ + ZV + g * 128 + c]) * rstd[s0 + e] * gn;
            u32x4 o; o.x = pk2(v[0], v[1]); o.y = pk2(v[2], v[3]); o.z = pk2(v[4], v[5]); o.w = pk2(v[6], v[7]);
            *(LAS u32x4*)(Bs + c * 136 + s0) = o; }
        __syncthreads();
        f32x4 acc[2][4]; mm128(As, Bs, acc, wr, wc, fr, fq);
        { unsigned short uu[2][4][4]; float bias[2][4];
#pragma unroll
          for (int mt = 0; mt < 2; ++mt)
#pragma unroll
            for (int i = 0; i < 4; ++i) { const int row = 32 * wr + 16 * mt + 4 * fq + i; bias[mt][i] = a.sg_b[(l * 4 + g) * 128 + row];
#pragma unroll
                for (int nt = 0; nt < 4; ++nt) uu[mt][i][nt] = Z[(size_t)(r0 + row) * NZ + ZU + g * 128 + 64 * wc + 16 * nt + fr]; }
#pragma unroll
          for (int mt = 0; mt < 2; ++mt)
#pragma unroll
            for (int i = 0; i < 4; ++i) { const int row = 32 * wr + 16 * mt + 4 * fq + i;
#pragma unroll
                for (int nt = 0; nt < 4; ++nt) { const int col = g * 128 + 64 * wc + 16 * nt + fr;
                    O[(size_t)(r0 + row) * 512 + col] = (bf16)(pk2(bf2f(uu[mt][i][nt]) * (acc[mt][nt][i] + bias[mt][i]), 0.f) & 0xffffu); } } }
        __syncthreads();
    }
}
__device__ __forceinline__ void pool_item(const Args& a, LAS unsigned char* lds, int l, int ci) {
    const int tid = TIDX, lane = tid & 63, w = tid >> 6, fr = lane & 15, fq = lane >> 4, wr = w >> 1, wc = w & 1;
    const int r0 = ci * 128;
    const int T = r0 < MP ? 256 : 1024, base = r0 < MP ? (r0 & ~255) : MP + ((r0 - MP) & ~1023), t0 = r0 - base;
    const bf16* Z = (const bf16*)(a.ws + WS_Z);
    bf16* O = (bf16*)(a.ws + WS_O3) + (size_t)2 * M * 512;
    LAS bf16* As = (LAS bf16*)lds; LAS bf16* Bs = (LAS bf16*)(lds + 34816); LAS bf16* Ts = (LAS bf16*)(lds + 69632);
    const int c = tid & 127, seg = tid >> 7;
    for (int g = 0; g < 4; ++g) {
        const int hw = 1 << g;
        stage_f32_tile_T(a.pool_w + ((size_t)l * 4 + g) * 16384, Bs);
#pragma unroll
        for (int it = 0; it < 5; ++it) { const int ch = tid + 512 * it;
            if (ch < 2304) { const int rr = ch >> 4, c8 = (ch & 15) * 8, tau = t0 - 8 + rr;
                u32x4 v = (u32x4){0u, 0u, 0u, 0u};
                if (tau >= 0 && tau < T) v = *(const u32x4*)(Z + (size_t)(base + tau) * NZ + ZP + g * 128 + c8);
                *(LAS u32x4*)(Ts + rr * 136 + c8) = v; } }
        __syncthreads();
        {
            const int ts = t0 + 32 * seg;
            const LAS bf16* tp = Ts + (32 * seg + 8) * 136 + c;
            float sum = 0.f;
            for (int dd = -hw; dd < hw; ++dd) sum += bf2f(tp[dd * 136]);
#pragma unroll 8
            for (int tt = 0; tt < 32; ++tt) { const int t = ts + tt;
                const int lo = t - hw < 0 ? 0 : t - hw, hi = t + hw > T ? T : t + hw;
                const float cur = bf2f(tp[tt * 136]);
                As[(32 * seg + tt) * 136 + c] = (bf16)(pk2(sum * frcp((float)(hi - lo)) - cur, 0.f) & 0xffffu);
                sum += bf2f(tp[(tt + hw) * 136]) - bf2f(tp[(tt - hw) * 136]); }
        }
        __syncthreads();
        f32x4 acc[2][4]; mm128(As, Bs, acc, wr, wc, fr, fq);
#pragma unroll
        for (int nt = 0; nt < 4; ++nt) { const int col = g * 128 + 64 * wc + 16 * nt + fr; const float sc = a.pool_scale[l * 512 + col];
#pragma unroll
            for (int mt = 0; mt < 2; ++mt)
#pragma unroll
                for (int i = 0; i < 4; ++i) { const int row = 32 * wr + 16 * mt + 4 * fq + i; O[(size_t)(r0 + row) * 512 + col] = (bf16)(pk2(acc[mt][nt][i] * sc, 0.f) & 0xffffu); } }
        __syncthreads();
    }
}
__device__ __forceinline__ void phase_mixers(const Args& a, LAS unsigned char* lds, int l) {
    for (int it = blockIdx.x; it < 480; it += (int)gridDim.x) {
        if (it < 256) { for (int rp = 0; rp <= ((REPMASK >> 10) & 1); ++rp) scan_item(a, lds, l, it >> 3, (it >> 1) & 3, it & 1, 0); }
        else if (it < 320) { const int p = it - 256; for (int rp = 0; rp <= ((REPMASK >> 10) & 1); ++rp) scan_item(a, lds, l, 32 + (p >> 5), (p >> 3) & 3, (p >> 2) & 1, p & 3); }
        else if (it < 400) { for (int rp = 0; rp <= ((REPMASK >> 11) & 1); ++rp) sg_item(a, lds, l, it - 320); }
        else { for (int rp = 0; rp <= ((REPMASK >> 12) & 1); ++rp) pool_item(a, lds, l, it - 400); }
    }
    for (int rp = 0; rp < ((REPMASK >> 13) & 1); ++rp) convert_set(a, lds, l, l == 0 ? 0x7e : 0x40, (int)blockIdx.x * 8 + (TIDX >> 6), (int)gridDim.x * 8);
    if (l == 0) convert_set(a, lds, 0, 0x1e, (int)blockIdx.x * 8 + (TIDX >> 6), (int)gridDim.x * 8);
}
__device__ __forceinline__ void phase_combine(const Args& a, int l, int bidx, int nblk) {
    const int lane = TIDX & 63, wave = TIDX >> 6;
    const int gw = bidx * 8 + wave, NGW = nblk * 8;
    const bf16* Z = (const bf16*)(a.ws + WS_Z); const bf16* OF = (const bf16*)(a.ws + WS_H); const bf16* OB = OF + (size_t)M * 512;
    bf16* O = (bf16*)(a.ws + WS_O3);
    const int c8 = 8 * lane;
    const f32x4 g0 = *(const f32x4*)(a.hg_norm + l * 128 + (c8 & 127)), g1 = *(const f32x4*)(a.hg_norm + l * 128 + (c8 & 127) + 4);
    for (int row = gw; row < MP; row += NGW) {
        const u32x4 f = *(const u32x4*)(OF + (size_t)row * 512 + c8), bb = *(const u32x4*)(OB + (size_t)row * 512 + c8), zg = *(const u32x4*)(Z + (size_t)row * NZ + ZG + c8);
        float v[8], ss = 0.f;
#pragma unroll
        for (int e = 0; e < 4; ++e) { v[2 * e] = bflo(f[e]) + bflo(bb[e]); v[2 * e + 1] = bfhi(f[e]) + bfhi(bb[e]); ss += v[2 * e] * v[2 * e] + v[2 * e + 1] * v[2 * e + 1]; }
        ss += __shfl_xor(ss, 1); ss += __shfl_xor(ss, 2); ss += __shfl_xor(ss, 4); ss += __shfl_xor(ss, 8);
        const float r = rsqrtf(ss * (1.f / 128.f) + EPS);
        u32x4 o;
        o.x = pk2(v[0] * r * g0[0] * bflo(zg.x), v[1] * r * g0[1] * bfhi(zg.x));
        o.y = pk2(v[2] * r * g0[2] * bflo(zg.y), v[3] * r * g0[3] * bfhi(zg.y));
        o.z = pk2(v[4] * r * g1[0] * bflo(zg.z), v[5] * r * g1[1] * bfhi(zg.z));
        o.w = pk2(v[6] * r * g1[2] * bflo(zg.w), v[7] * r * g1[3] * bfhi(zg.w));
        *(u32x4*)(O + (size_t)row * 512 + c8) = o;
    }
}
__device__ __forceinline__ void sample_combine_item(const Args& a, LAS unsigned char* lds, int l, int sq, int tseg, int h, int hf0) {
    const int tid = TIDX, lane = tid & 63, w = tid >> 6, fr = lane & 15, fq = lane >> 4, wr = w >> 1, wc = w & 1;
    LAS bf16* As = (LAS bf16*)lds; LAS bf16* Bs = (LAS bf16*)(lds + 34816); LAS float* Ct = (LAS float*)lds;
    const bf16* Z = (const bf16*)(a.ws + WS_Z); const bf16* OF = (const bf16*)(a.ws + WS_H); const bf16* OB = OF + (size_t)M * 512;
    bf16* O = (bf16*)(a.ws + WS_O3);
    const float* SL = (const float*)(a.ws + WS_SL); const float* AS = (const float*)(a.ws + WS_AS);
    const int hf = hf0;
    f32x4 acc[2][4];
#pragma unroll
    for (int mt = 0; mt < 2; ++mt)
#pragma unroll
        for (int nt = 0; nt < 4; ++nt) acc[mt][nt] = (f32x4){0.f, 0.f, 0.f, 0.f};
    for (int d = 0; d < 2; ++d) {
        const int g = d == 0 ? tseg : 3 - tseg;
        if (g == 0) continue;
        const int ib = ((sq * 4 + h) * 2 + d) * 4;
#pragma unroll
        for (int it = 0; it < 4; ++it) { const int p = tid + 512 * it, v = p & 127, k0 = (p >> 7) * 8;
            float E[8];
#pragma unroll
            for (int e = 0; e < 8; ++e) E[e] = SL[(size_t)ib * 16384 + (k0 + e) * 128 + v];
            for (int gg = 1; gg < g; ++gg) {
#pragma unroll
                for (int e = 0; e < 8; ++e) E[e] = E[e] * AS[(ib + gg) * 128 + k0 + e] + SL[(size_t)(ib + gg) * 16384 + (k0 + e) * 128 + v]; }
            u32x4 o; o.x = pk2(E[0], E[1]); o.y = pk2(E[2], E[3]); o.z = pk2(E[4], E[5]); o.w = pk2(E[6], E[7]);
            *(LAS u32x4*)(Bs + v * 136 + k0) = o; }
        const bf16* QC = (const bf16*)(a.ws + WS_QC) + (size_t)(((sq * 4 + h) * 2 + d) * 1024 + 256 * tseg) * 128;
        {
#pragma unroll
            for (int it = 0; it < 4; ++it) { const int ch = tid + 512 * it, r = ch >> 4, c8 = (ch & 15) * 8;
                *(LAS u32x4*)(As + r * 136 + c8) = *(const u32x4*)(QC + (size_t)(128 * hf + r) * 128 + c8); }
            __syncthreads();
            mm128(As, Bs, acc, wr, wc, fr, fq, false);
            __syncthreads();
        }
    }
    const float gn0 = a.hg_norm[l * 128 + 2 * lane], gn1 = a.hg_norm[l * 128 + 2 * lane + 1];
    {
#pragma unroll
        for (int mt = 0; mt < 2; ++mt)
#pragma unroll
            for (int nt = 0; nt < 4; ++nt)
#pragma unroll
                for (int i = 0; i < 4; ++i) Ct[(32 * wr + 16 * mt + 4 * fq + i) * 132 + 64 * wc + 16 * nt + fr] = acc[mt][nt][i];
        __syncthreads();
        { unsigned pf_[16], pb_[16], zg[16];
          const int grow0 = MP + sq * 1024 + 256 * tseg + 128 * hf + 16 * w;
#pragma unroll
          for (int rr = 0; rr < 16; ++rr) { const size_t go = (size_t)(grow0 + rr) * 512 + h * 128 + 2 * lane;
              pf_[rr] = *(const unsigned*)(OF + go); pb_[rr] = *(const unsigned*)(OB + go); zg[rr] = *(const unsigned*)(Z + (size_t)(grow0 + rr) * NZ + ZG + h * 128 + 2 * lane); }
#pragma unroll
          for (int rr = 0; rr < 16; ++rr) { const int r = 16 * w + rr; const size_t go = (size_t)(grow0 + rr) * 512 + h * 128 + 2 * lane;
              const float v0 = Ct[r * 132 + 2 * lane] + bflo(pf_[rr]) + bflo(pb_[rr]), v1 = Ct[r * 132 + 2 * lane + 1] + bfhi(pf_[rr]) + bfhi(pb_[rr]);
              const float rs = rsqrtf(wave_sum(v0 * v0 + v1 * v1) * (1.f / 128.f) + EPS);
              *(unsigned*)(O + go) = pk2(v0 * rs * gn0 * bflo(zg[rr]), v1 * rs * gn1 * bfhi(zg[rr])); } }
        __syncthreads();
    }
}
__device__ __forceinline__ void phase_conv(const Args& a, int l) {
    const bf16* HF = (const bf16*)(a.ws + WS_Z); bf16* ACT = (bf16*)(a.ws + WS_O3);
    const float* cw = a.conv_w + (size_t)l * 3 * NUP; const float* cb = a.conv_b + (size_t)l * NUP;
    const int total = (M / 8) * 352;
    for (int idx = blockIdx.x * 512 + TIDX; idx < total; idx += (int)gridDim.x * 512) {
        const int run = idx / 352, j0 = (idx - run * 352) * 8, row0 = run * 8;
        const int t0 = row0 < MP ? (row0 & 255) : ((row0 - MP) & 1023), T = row0 < MP ? 256 : 1024;
        float r[2][8][8];
#pragma unroll
        for (int hf = 0; hf < 2; ++hf) { const int col = hf * DFF + j0; const bf16* hp0 = HF + (size_t)row0 * NUP + col;
            u32x4 h[10];
#pragma unroll
            for (int q = 0; q < 10; ++q) { const int t = t0 - 1 + q; h[q] = (t >= 0 && t < T) ? *(const u32x4*)(hp0 + (ptrdiff_t)(q - 1) * NUP) : (u32x4){0u, 0u, 0u, 0u}; }
            const f32x4 wa0 = *(const f32x4*)(cw + col), wa1 = *(const f32x4*)(cw + col + 4), wb0 = *(const f32x4*)(cw + NUP + col), wb1 = *(const f32x4*)(cw + NUP + col + 4);
            const f32x4 wc0 = *(const f32x4*)(cw + 2 * NUP + col), wc1 = *(const f32x4*)(cw + 2 * NUP + col + 4), bi0 = *(const f32x4*)(cb + col), bi1 = *(const f32x4*)(cb + col + 4);
#pragma unroll
            for (int e = 0; e < 4; ++e) {
                const float w0l = e < 2 ? wa0[2 * e] : wa1[2 * e - 4], w0h = e < 2 ? wa0[2 * e + 1] : wa1[2 * e - 3];
                const float w1l = e < 2 ? wb0[2 * e] : wb1[2 * e - 4], w1h = e < 2 ? wb0[2 * e + 1] : wb1[2 * e - 3];
                const float w2l = e < 2 ? wc0[2 * e] : wc1[2 * e - 4], w2h = e < 2 ? wc0[2 * e + 1] : wc1[2 * e - 3];
                const float bl = e < 2 ? bi0[2 * e] : bi1[2 * e - 4], bh = e < 2 ? bi0[2 * e + 1] : bi1[2 * e - 3];
#pragma unroll
                for (int q = 0; q < 8; ++q) {
                    r[hf][q][2 * e] = w0l * bflo(h[q][e]) + w1l * bflo(h[q + 1][e]) + w2l * bflo(h[q + 2][e]) + bl;
                    r[hf][q][2 * e + 1] = w0h * bfhi(h[q][e]) + w1h * bfhi(h[q + 1][e]) + w2h * bfhi(h[q + 2][e]) + bh; } } }
#pragma unroll
        for (int q = 0; q < 8; ++q) { u32x4 o;
            o.x = pk2(silu_f(r[0][q][0]) * r[1][q][0], silu_f(r[0][q][1]) * r[1][q][1]); o.y = pk2(silu_f(r[0][q][2]) * r[1][q][2], silu_f(r[0][q][3]) * r[1][q][3]);
            o.z = pk2(silu_f(r[0][q][4]) * r[1][q][4], silu_f(r[0][q][5]) * r[1][q][5]); o.w = pk2(silu_f(r[0][q][6]) * r[1][q][6], silu_f(r[0][q][7]) * r[1][q][7]);
            *(u32x4*)(ACT + (size_t)(row0 + q) * DFF + j0) = o; }
    }
}

#define XB_TMO      128
#define XB_XCNT(j)  (256  + 64 * (j))
#define XB_XSUB(j)  (1280 + 64 * (j))
#define XB_XGEN(j)  (2304 + 64 * (j))
#define XB_TOP      3328
#define XB_TOPGEN   3392
#define XCD_BAR_WORDS 3456
#define XB_SPIN_CAP (1u << 18)

__device__ __forceinline__ unsigned xb_ld(unsigned* p)              { return __hip_atomic_load(p, __ATOMIC_RELAXED, __HIP_MEMORY_SCOPE_AGENT); }
__device__ __forceinline__ unsigned xb_add(unsigned* p, unsigned v) { return __hip_atomic_fetch_add(p, v, __ATOMIC_RELAXED, __HIP_MEMORY_SCOPE_AGENT); }
__device__ __forceinline__ unsigned xb_xcc_id() { return (unsigned)__builtin_amdgcn_s_getreg((3 << 11) | 20) & 0xFu; }
#define XB_SPIN(cond, bar) do { unsigned _sp = 0; while (cond) { __builtin_amdgcn_s_sleep(1); \
    if ((++_sp & 255u) == 0u) { if (xb_ld(&(bar)[XB_TMO])) break; if (_sp > XB_SPIN_CAP) { atomicAdd(&(bar)[XB_TMO], 1u); break; } } } } while (0)

struct XcdBarrier {
    unsigned* bar; unsigned x;
    volatile LAS unsigned* st;
};

__device__ __forceinline__ XcdBarrier xcd_barrier_post(unsigned* bar, volatile LAS unsigned* st) {
    XcdBarrier b; b.bar = bar; b.x = xb_xcc_id(); b.st = st;
    if (threadIdx.x == 0) (void)xb_add(&bar[XB_XCNT(b.x)], 1u);
    return b;
}
__device__ __forceinline__ void xcd_barrier_complete(unsigned* bar, unsigned x, unsigned& nloc, unsigned& nx) {
    const unsigned G = gridDim.x * gridDim.y * gridDim.z;
    unsigned sum, cnt, mine, sp = 0u;
    for (;;) {
        sum = 0u; cnt = 0u; mine = 0u;
#pragma unroll
        for (unsigned j = 0; j < 16; ++j) { const unsigned c = xb_ld(&bar[XB_XCNT(j)]); sum += c; cnt += (c > 0u) ? 1u : 0u; mine = (j == x) ? c : mine; }
        if (sum == G) break;
        __builtin_amdgcn_s_sleep(1);
        if ((++sp & 255u) == 0u) { if (xb_ld(&bar[XB_TMO])) break; if (sp > XB_SPIN_CAP) { atomicAdd(&bar[XB_TMO], 1u); break; } }
    }
    nloc = mine > 0u ? mine : 1u; nx = cnt > 0u ? cnt : 1u;
}

__device__ __forceinline__ void xcd_barrier(const XcdBarrier& b) {
    asm volatile("s_waitcnt vmcnt(0)" ::: "memory");
    __syncthreads();
    if (threadIdx.x == 0) {
        unsigned* bar = b.bar;
        __builtin_amdgcn_s_waitcnt(0);
        unsigned nloc = b.st[0], nx = b.st[1];
        if (nloc == 0u) { xcd_barrier_complete(bar, b.x, nloc, nx); b.st[0] = nloc; b.st[1] = nx; }
        const unsigned old = xb_add(&bar[XB_XSUB(b.x)], 1u);
        const unsigned gen = old / nloc;
        if (old + 1u == (gen + 1u) * nloc) {
            __builtin_amdgcn_fence(__ATOMIC_RELEASE, "agent");
            asm volatile("s_waitcnt vmcnt(0)" ::: "memory");
            const unsigned og = xb_add(&bar[XB_TOP], 1u);
            const unsigned tg = og / nx;
            if (og + 1u == (tg + 1u) * nx) xb_add(&bar[XB_TOPGEN], 1u);
            else XB_SPIN(xb_ld(&bar[XB_TOPGEN]) == tg, bar);
            __builtin_amdgcn_fence(__ATOMIC_ACQUIRE, "agent");
            xb_add(&bar[XB_XGEN(b.x)], 1u);
            asm volatile("s_waitcnt vmcnt(0)" ::: "memory");
        } else {
            XB_SPIN(xb_ld(&bar[XB_XGEN(b.x)]) == gen, bar);
            __builtin_amdgcn_fence(__ATOMIC_ACQUIRE, "agent");
            asm volatile("s_waitcnt vmcnt(0)" ::: "memory");
        }
    }
    __syncthreads();
}

__global__ void __launch_bounds__(512, 2) fwd_kernel(Args a) {
    extern __shared__ __attribute__((aligned(16))) unsigned char lds_raw[];
    LAS unsigned char* lds = (LAS unsigned char*)lds_raw;
    cg::grid_group grid = cg::this_grid();
    unsigned char* ws = a.ws;
    const int G = gridDim.x, bid = blockIdx.x;
    if (threadIdx.x < 4) ((volatile LAS unsigned*)(lds + 131072 + 64))[threadIdx.x] = 0u;
    __syncthreads();
    const XcdBarrier bar = xcd_barrier_post((unsigned*)(a.ws + WS_BAR), (volatile LAS unsigned*)(lds + 131072 + 64));
    for (int ph = a.ph_lo; ph < a.ph_hi; ++ph) {
        if (ph == 0 && PHSEL(100)) { phase_mods(a, lds); convert_set(a, lds, 0, 1, bid * 8 + (TIDX >> 6), G * 8); }
        else if (ph == NPHASE - 1 && PHSEL(101)) { phase_final(a); }
        else {
            const int l = (ph - 1) / 10, sp = (ph - 1) % 10;
            for (int rep = 0; rep <= ((REPMASK >> sp) & 1); ++rep) {
            const float* mods = (const float*)(ws + WS_MOD) + (size_t)l * 3 * NMOD;
            if ((sp == 0 || sp == 6) && PHSEL(0)) { phase_norm(a, l, (sp == 0 ? a.norm_mix : a.norm_ffn) + l * D, sp == 0 ? 0 : 3 * D, sp == 0 && l == 0); }
            else if ((sp == 1 || sp == 7) && PHSEL(1)) {
                const bool up = sp == 7;
                pg8::Gemm g{(const bf16*)(ws + WS_H), (const bf16*)(ws + (up ? WS_WUP : WS_WIN)), M, up ? NUP : NZ, D}; pg8::StaticOrder S; S.init(M, up ? NUP : NZ, G, bid);
                pg8::EpiZ E{(bf16*)(ws + WS_Z), up ? NUP : NZ, up ? 1 : 0}; pg8::gemm_phase<pg8::EpiZ, pg8::StaticOrder, true, true>(lds, g, S, E); }
            else if (sp == 2 && PHSEL(2)) { phase_mixers(a, lds, l); }
            else if (sp == 3 && PHSEL(3)) { if (bid < 64) sample_combine_item(a, lds, l, bid >> 5, (bid >> 3) & 3, (bid >> 1) & 3, bid & 1); else phase_combine(a, l, bid - 64, G - 64); }
            else if (sp == 4 && PHSEL(4)) { pg8::Gemm g{(const bf16*)(ws + WS_O3), (const bf16*)(ws + WS_WBR), M, D, 512}; pg8::TileOrder S{bid, 3};
                pg8::EpiBranch E{(const bf16*)(ws + WS_Z), (bf16*)(ws + WS_H)}; pg8::gemm_phase<pg8::EpiBranch, pg8::TileOrder, true, true>(lds, g, S, E);
                if ((bid >> 3) >= 20) convert_set(a, lds, l, l == 0 ? 0x60 : 0x40, ((bid >> 3) - 20) * 64 + (bid & 7) * 8 + (TIDX >> 6), 12 * 64); }
            else if ((sp == 5 || (sp == 9 && l == 0)) && PHSEL(5)) {
                const bool dn = sp == 9;
                pg8::Gemm g{(const bf16*)(ws + (dn ? WS_O3 : WS_H)), (const bf16*)(ws + (dn ? WS_WDN : WS_WOUT)), M, D, dn ? DFF : D}; pg8::TileOrder S{bid, 1};
                pg8::EpiResid E{a.out, mods + (dn ? 5 * D : 2 * D)}; pg8::gemm_phase<pg8::EpiResid, pg8::TileOrder, true, true>(lds, g, S, E);
                if (dn && (bid >> 3) >= 20) convert_set(a, lds, 1, 0x3f, ((bid >> 3) - 20) * 64 + (bid & 7) * 8 + (TIDX >> 6), 12 * 64); }
            else if (sp == 9 && PHSEL(9)) {
                pg8::Gemm g{(const bf16*)(ws + WS_O3), (const bf16*)(ws + WS_WDN), M, D, DFF}; pg8::SplitOrder S{bid, 30, 14};
                pg8::EpiResidSplit E{pg8::EpiResid{a.out, mods + 5 * D}, (float*)(ws + WS_Z), (unsigned*)(ws + WS_BAR) + 3600 + l * 160, bid};
                pg8::gemm_phase<pg8::EpiResidSplit, pg8::SplitOrder, true, true>(lds, g, S, E); }
            else if (sp == 8 && PHSEL(8)) { phase_conv(a, l); }
            }
        }
        if (ph + 1 < a.ph_hi) { if (a.ph_hi > 1000) grid.sync(); else xcd_barrier(bar); }
    }
}

extern "C" void kernel_launch(void* const* d_in, const int* in_sizes, int n_in, void* d_out, int out_size, void* d_ws, size_t ws_size, hipStream_t stream) {
    static int grid = 0;
    if (grid == 0) {
        if (n_in != 26 || ws_size < WS_END) { fprintf(stderr, "kernel_launch: expected 26 inputs and >= %zu bytes of workspace (got %d, %zu)\n", (size_t)WS_END, n_in, ws_size); grid = -1; return; }
        int dev = 0, cus = 0, per_cu = 0;
        hipGetDevice(&dev); hipDeviceGetAttribute(&cus, hipDeviceAttributeMultiprocessorCount, dev);
        if (hipFuncSetAttribute((const void*)fwd_kernel, hipFuncAttributeMaxDynamicSharedMemorySize, LDS_BYTES) != hipSuccess) { fprintf(stderr, "kernel_launch: hipFuncSetAttribute failed\n"); grid = -1; return; }
        hipOccupancyMaxActiveBlocksPerMultiprocessor(&per_cu, (const void*)fwd_kernel, 512, LDS_BYTES);
        if (per_cu < 1) { fprintf(stderr, "kernel_launch: occupancy query says %d blocks per CU\n", per_cu); per_cu = 1; }
        (void)hipGetLastError();
        grid = cus;
    }
    if (grid < 0) return;
    if (hipMemsetAsync((char*)d_ws + WS_BAR, 0, 16384, stream) != hipSuccess) { fprintf(stderr, "kernel_launch: memset failed\n"); return; }
    Args a{};
    const float** p = (const float**)&a;
    for (int i = 0; i < 26; ++i) p[i] = (const float*)d_in[i];
    a.out = (float*)d_out; a.ws = (unsigned char*)d_ws;
#if MK_SPLIT
    for (int ph = 0; ph < NPHASE; ++ph) { a.ph_lo = ph; a.ph_hi = ph + 1; hipLaunchKernelGGL(fwd_kernel, dim3(grid), dim3(512), LDS_BYTES, stream, a); }
#else
    a.ph_lo = 0; a.ph_hi = NPHASE;
    void* args[] = {&a};
    hipError_t e = hipLaunchCooperativeKernel((const void*)fwd_kernel, dim3(grid), dim3(512), args, LDS_BYTES, stream);
    if (e != hipSuccess) fprintf(stderr, "cooperative launch failed: %s (grid %d)\n", hipGetErrorString(e), grid);
#endif
}
```

```cpp
#include <hip/hip_runtime.h>
#include <hip/hip_cooperative_groups.h>
#include <cstdio>
#include <cstdint>
namespace cg = cooperative_groups;

#ifndef MK_SPLIT
#define MK_SPLIT 0
#endif

#ifndef REPMASK
#define REPMASK 0
#endif
#ifndef PHSEL
#define PHSEL(x) true
#endif
#define LAS __attribute__((address_space(3)))
__device__ __forceinline__ int opaque_tid() { int t = (int)threadIdx.x; asm volatile("" : "+v"(t)); return t; }
#define TIDX opaque_tid()
typedef unsigned short bf16;
typedef float f32x4 __attribute__((ext_vector_type(4)));
typedef short bf16x8 __attribute__((ext_vector_type(8)));
typedef short s16x4 __attribute__((ext_vector_type(4)));
typedef unsigned u32x4 __attribute__((ext_vector_type(4)));
typedef unsigned u32x2 __attribute__((ext_vector_type(2)));

__device__ __forceinline__ float bf2f(unsigned v) { return __uint_as_float(v << 16); }
__device__ __forceinline__ float bflo(unsigned w) { return __uint_as_float(w << 16); }
__device__ __forceinline__ float bfhi(unsigned w) { return __uint_as_float(w & 0xffff0000u); }
__device__ __forceinline__ unsigned f2bf(float f) { unsigned u = __float_as_uint(f); return (u + 0x7fffu + ((u >> 16) & 1u)) >> 16; }
typedef float f32x2_t __attribute__((ext_vector_type(2))); typedef __bf16 bf16x2_t __attribute__((ext_vector_type(2)));
__device__ __forceinline__ unsigned pk2(float lo, float hi) { f32x2_t v = {lo, hi}; bf16x2_t b = __builtin_convertvector(v, bf16x2_t); return __builtin_bit_cast(unsigned, b); }
__device__ __forceinline__ float frcp(float x) { return __builtin_amdgcn_rcpf(x); }
__device__ __forceinline__ float sigm(float x) { return frcp(1.f + __expf(-x)); }
__device__ __forceinline__ float silu_f(float x) { return x * sigm(x); }
__device__ __forceinline__ float gelu_f(float x) { return x * sigm(1.5957691216057308f * (x + 0.044715f * x * x * x)); }
__device__ __forceinline__ float wave_sum(float v) {
#pragma unroll
    for (int o = 1; o < 64; o <<= 1) v += __shfl_xor(v, o);
    return v;
}

namespace pg8 {
#define PG8_LAS __attribute__((address_space(3)))
typedef unsigned short bf16_t;
constexpr int BM = 256, BK = 64, HALF = 128, HTB = HALF * BK * 2, STAGE_BYTES = 8 * HTB, NXCD = 8, WGM = 4;
__host__ __device__ __forceinline__ int lds_byte(int r, int c) { const int st = (r >> 4) * 2 + (c >> 5), rr = r & 15, cc = c & 31, ob = rr * 64 + cc * 2; return st * 1024 + (ob ^ (((ob >> 9) & 1) << 5)); }
__host__ __device__ __forceinline__ void stage_rc(int b, int& R, int& C) { const int st = b / 1024, sb = b % 1024, swz = sb ^ (((sb >> 9) & 1) << 5); R = (st >> 1) * 16 + swz / 64; C = (st & 1) * 32 + (swz % 64) / 2; }
__host__ __device__ __forceinline__ int perm32(int rho) { const int n = rho >> 4, i = rho & 15; return 8 * (i >> 2) + 4 * n + (i & 3); }
struct Unit { int pm, pn; };
struct Gemm { const bf16_t* A; const bf16_t* Bt; int M, N, K; };
struct StaticOrder {
    int nM, nN, nwg, G, c;
    __host__ __device__ void init(int M, int N, int G_, int c_) { nM = M / BM; nN = N / BM; nwg = nM * nN; G = G_; c = c_; }
    __host__ __device__ bool next(int i, Unit& u) const {
        const long L = (long)i * G + c; if (L >= nwg) return false;
        int wgid = (int)L; { const int q = nwg / NXCD, r = nwg % NXCD, xcd = wgid % NXCD, off = wgid / NXCD; wgid = (xcd < r ? xcd * (q + 1) : r * (q + 1) + (xcd - r) * q) + off; }
        const int nig = WGM * nN, gid = wgid / nig, fm = gid * WGM, gsz = (nM - fm) < WGM ? (nM - fm) : WGM;
        u.pm = fm + ((wgid % nig) % gsz); u.pn = (wgid % nig) / gsz; return true;
    }
    __device__ __forceinline__ void a_ready(const Unit&) const {}
    __device__ __forceinline__ void done(const Unit&) const {}
};
struct TileOrder {
    int c, nch;
    __device__ bool next(int i, Unit& u) const {
        const int xcd = c & 7, slot = c >> 3; if (slot >= 20 || i >= nch) return false;
        const int L = xcd * 20 + slot; u.pm = i * 40 + (L >> 2); u.pn = i * 4 + (L & 3); return true;
    }
    __device__ __forceinline__ void a_ready(const Unit&) const {}
    __device__ __forceinline__ void done(const Unit&) const {}
};
__device__ __forceinline__ unsigned cvt_pk_bf16(float lo, float hi) { return pk2(lo, hi); }

struct EpiStore {
    static constexpr bool PERM = true, AFTER_DRAIN = false;
    bf16_t* O; int ldc;
    __device__ __forceinline__ bool zero_after(const Unit&) const { return true; }
    __device__ __forceinline__ void operator()(f32x4 (&acc)[2][2][4][2], const Unit& u, int wr, int wc, int fr, int fq) const {
        const int row0 = u.pm * BM + wr * 64 + fr, col0 = u.pn * BM + wc * 32 + 8 * fq;
#pragma unroll
        for (int ai = 0; ai < 2; ++ai)
#pragma unroll
            for (int m = 0; m < 4; ++m) { bf16_t* rowp = O + (size_t)(row0 + ai * HALF + m * 16) * ldc + col0;
#pragma unroll
                for (int bj = 0; bj < 2; ++bj) { const f32x4 v0 = acc[ai][bj][m][0], v1 = acc[ai][bj][m][1];
                    u32x4 w; w.x = cvt_pk_bf16(v0[0], v0[1]); w.y = cvt_pk_bf16(v0[2], v0[3]); w.z = cvt_pk_bf16(v1[0], v1[1]); w.w = cvt_pk_bf16(v1[2], v1[3]);
                    *(u32x4*)(rowp + bj * HALF) = w; } }
    }
};
struct EpiZ {
    static constexpr bool PERM = true, AFTER_DRAIN = false;
    bf16_t* O; int ldc; int plain;
    __device__ __forceinline__ bool zero_after(const Unit&) const { return true; }
    __device__ __forceinline__ void operator()(f32x4 (&acc)[2][2][4][2], const Unit& u, int wr, int wc, int fr, int fq) const {
        const int row0 = u.pm * BM + wr * 64 + fr, col0 = u.pn * BM + wc * 32 + 8 * fq;
        const int pn = u.pn;
        const int mode = plain ? 0 : pn < 2 ? 1 : (pn < 8 ? 0 : (pn < 10 ? 2 : (pn < 14 ? 3 : (pn < 16 ? 0 : 4))));
#pragma unroll
        for (int ai = 0; ai < 2; ++ai)
#pragma unroll
            for (int m = 0; m < 4; ++m) { bf16_t* rowp = O + (size_t)(row0 + ai * HALF + m * 16) * ldc + col0;
#pragma unroll
                for (int bj = 0; bj < 2; ++bj) { float v[8];
#pragma unroll
                    for (int e = 0; e < 4; ++e) { v[e] = acc[ai][bj][m][0][e]; v[4 + e] = acc[ai][bj][m][1][e]; }
                    if (mode == 1) {
#pragma unroll
                        for (int e = 0; e < 8; ++e) v[e] = v[e] * sigm(v[e]) * 0.08838834764831845f;
                    } else if (mode == 2) {
#pragma unroll
                        for (int e = 0; e < 8; ++e) v[e] = v[e] * sigm(v[e]);
                    } else if (mode == 3) {
#pragma unroll
                        for (int e = 0; e < 8; ++e) v[e] = gelu_f(v[e]);
                    } else if (mode == 4) {
#pragma unroll
                        for (int e = 0; e < 8; ++e) v[e] = sigm(v[e]);
                    }
                    u32x4 w; w.x = cvt_pk_bf16(v[0], v[1]); w.y = cvt_pk_bf16(v[2], v[3]); w.z = cvt_pk_bf16(v[4], v[5]); w.w = cvt_pk_bf16(v[6], v[7]);
                    *(u32x4*)(rowp + bj * HALF) = w; } }
    }
};
struct EpiResid {
    static constexpr bool PERM = true, AFTER_DRAIN = false;
    float* X; const float* gate;
    __device__ __forceinline__ bool zero_after(const Unit&) const { return true; }
    __device__ __forceinline__ void operator()(f32x4 (&acc)[2][2][4][2], const Unit& u, int wr, int wc, int fr, int fq) const {
        const int modrow = u.pm < 32 ? 0 : 1 + ((u.pm - 32) >> 2);
        const int row0 = u.pm * BM + wr * 64 + fr, col0 = u.pn * BM + wc * 32 + 8 * fq;
        const float* g = gate + modrow * 6144 + col0;
        f32x4 gv[2][2];
#pragma unroll
        for (int bj = 0; bj < 2; ++bj) { gv[bj][0] = *(const f32x4*)(g + bj * HALF); gv[bj][1] = *(const f32x4*)(g + bj * HALF + 4); }
#pragma unroll
        for (int ai = 0; ai < 2; ++ai) {
            f32x4 xv[4][2][2];
#pragma unroll
            for (int m = 0; m < 4; ++m) { const float* rowp = X + (size_t)(row0 + ai * HALF + m * 16) * 1024 + col0;
#pragma unroll
                for (int bj = 0; bj < 2; ++bj) { xv[m][bj][0] = *(const f32x4*)(rowp + bj * HALF); xv[m][bj][1] = *(const f32x4*)(rowp + bj * HALF + 4); } }
#pragma unroll
            for (int m = 0; m < 4; ++m) { float* rowp = X + (size_t)(row0 + ai * HALF + m * 16) * 1024 + col0;
#pragma unroll
                for (int bj = 0; bj < 2; ++bj) {
                    *(f32x4*)(rowp + bj * HALF) = xv[m][bj][0] + gv[bj][0] * acc[ai][bj][m][0]; *(f32x4*)(rowp + bj * HALF + 4) = xv[m][bj][1] + gv[bj][1] * acc[ai][bj][m][1]; } }
            asm volatile("" ::: "memory"); }
    }
};
struct EpiBranch {
    static constexpr bool PERM = true, AFTER_DRAIN = false;
    const bf16_t* Z; bf16_t* O;
    __device__ __forceinline__ bool zero_after(const Unit& u) const { return u.pm >= 80; }
    __device__ __forceinline__ void operator()(f32x4 (&acc)[2][2][4][2], const Unit& u, int wr, int wc, int fr, int fq) const {
        const int br = u.pm / 40, pm = u.pm - br * 40, pn = u.pn - br * 4;
        const int row0 = pm * BM + wr * 64 + fr, col0 = pn * BM + wc * 32 + 8 * fq;
#pragma unroll
        for (int ai = 0; ai < 2; ++ai) {
            u32x4 gcv[4][2], gnv[4][2];
#pragma unroll
            for (int m = 0; m < 4; ++m)
#pragma unroll
                for (int bj = 0; bj < 2; ++bj) { const bf16_t* zq_ = Z + (size_t)(row0 + ai * HALF + m * 16) * 7168 + 4096 + br * 1024 + col0 + bj * HALF;
                    gcv[m][bj] = *(const u32x4*)zq_; gnv[m][bj] = br < 2 ? *(const u32x4*)(zq_ + 1024) : (u32x4){0u, 0u, 0u, 0u}; }
#pragma unroll
            for (int m = 0; m < 4; ++m) { const int row = row0 + ai * HALF + m * 16;
#pragma unroll
                for (int bj = 0; bj < 2; ++bj) {
                    const bf16_t* zp = Z + (size_t)row * 7168 + 4096 + br * 1024 + col0 + bj * HALF;
                    const u32x4 gc = gcv[m][bj];
                    float f[8];
                    if (br < 2) { const u32x4 gn = gnv[m][bj];
#pragma unroll
                        for (int e = 0; e < 4; ++e) { f[2 * e] = bflo(gc[e]) * frcp(fmaxf(bflo(gn[e]), 1e-20f)); f[2 * e + 1] = bfhi(gc[e]) * frcp(fmaxf(bfhi(gn[e]), 1e-20f)); }
                    } else {
#pragma unroll
                        for (int e = 0; e < 4; ++e) { f[2 * e] = bflo(gc[e]); f[2 * e + 1] = bfhi(gc[e]); }
                    }
                    f32x4 v0 = acc[ai][bj][m][0], v1 = acc[ai][bj][m][1];
                    v0[0] *= f[0]; v0[1] *= f[1]; v0[2] *= f[2]; v0[3] *= f[3]; v1[0] *= f[4]; v1[1] *= f[5]; v1[2] *= f[6]; v1[3] *= f[7];
                    if (br < 2) { acc[ai][bj][m][0] = v0; acc[ai][bj][m][1] = v1; }
                    else { u32x4 w; w.x = cvt_pk_bf16(v0[0], v0[1]); w.y = cvt_pk_bf16(v0[2], v0[3]); w.z = cvt_pk_bf16(v1[0], v1[1]); w.w = cvt_pk_bf16(v1[2], v1[3]);
                        *(u32x4*)(O + (size_t)row * 1024 + col0 + bj * HALF) = w; }
                } } }
    }
};

template <class Epi, class Sched, bool ALIGN_EPI = false, bool SP2 = false>
__device__ __forceinline__ void gemm_phase(PG8_LAS unsigned char* lds, const Gemm g, const Sched& S, const Epi& E) {
    const int tid = TIDX, wid = __builtin_amdgcn_readfirstlane(tid >> 6), lane = tid & 63, wr = wid >> 2, wc = wid & 3, fr = lane & 15, fq = lane >> 4;
    const int K = g.K, nt = K / BK;
    unsigned voffA[2], voffB[2];
#pragma unroll
    for (int i = 0; i < 2; ++i) { int R, C; stage_rc(tid * 16 + i * 8192, R, C); const int Rb = Epi::PERM ? ((R & ~31) + perm32(R & 31)) : R;
        voffA[i] = (unsigned)(R * K + C) * 2u; voffB[i] = (unsigned)(Rb * K + C) * 2u; }
    const size_t kstep = (size_t)(BK * 2);
    const size_t hstep = (size_t)HALF * K * 2;
    const size_t tstep = 2 * hstep;
    const unsigned ldsw = (unsigned)wid * 1024u;
    const int aoff = lds_byte(wr * 64 + fr, fq * 8), boff = lds_byte(wc * 32 + fr, fq * 8);
#define PG8_SA(b, h) (((b) * 2 + (h)) * HTB)
#define PG8_SB(b, h) ((4 + (b) * 2 + (h)) * HTB)
#define PG8_STAGE(bufoff, gbase, voff) do { _Pragma("unroll") for (int _i = 0; _i < 2; ++_i) \
        __builtin_amdgcn_global_load_lds((const unsigned*)((const char*)(gbase) + (voff)[_i]), (PG8_LAS unsigned*)(lds + (bufoff) + ldsw + _i * 8192), 16, 0, 0); } while (0)
#define PG8_LDA(dst, b, h) do { _Pragma("unroll") for (int m = 0; m < 4; ++m) _Pragma("unroll") for (int k = 0; k < 2; ++k) dst[m][k] = *(const PG8_LAS bf16x8*)(lds + PG8_SA(b, h) + aoff + m * 2048 + k * 1024); } while (0)
#define PG8_LDB(dst, b, h) do { _Pragma("unroll") for (int n = 0; n < 2; ++n) _Pragma("unroll") for (int k = 0; k < 2; ++k) dst[n][k] = *(const PG8_LAS bf16x8*)(lds + PG8_SB(b, h) + boff + n * 2048 + k * 1024); } while (0)
#define PG8_MMA(ai, bj, At, Bt) do { __builtin_amdgcn_s_setprio(1); _Pragma("unroll") for (int m = 0; m < 4; ++m) _Pragma("unroll") for (int n = 0; n < 2; ++n) _Pragma("unroll") for (int k = 0; k < 2; ++k) \
        acc[ai][bj][m][n] = __builtin_amdgcn_mfma_f32_16x16x32_bf16(Bt[n][k], At[m][k], acc[ai][bj][m][n], 0, 0, 0); __builtin_amdgcn_s_setprio(0); } while (0)
#define PG8_WAIT_V(n) asm volatile("s_waitcnt vmcnt(" #n ")" ::: "memory")
#define PG8_WAIT_L(n) asm volatile("s_waitcnt lgkmcnt(" #n ")" ::: "memory")
#define PG8_BAR __builtin_amdgcn_s_barrier()
#define PG8_SCHED __builtin_amdgcn_sched_barrier(0)
    Unit cur, nxt; int ui = 0;
    if (!S.next(0, cur)) return;
    f32x4 acc[2][2][4][2];
#pragma unroll
    for (int a = 0; a < 2; ++a)
#pragma unroll
        for (int b = 0; b < 2; ++b)
#pragma unroll
            for (int m = 0; m < 4; ++m)
#pragma unroll
                for (int n = 0; n < 2; ++n) acc[a][b][m][n] = (f32x4){0.f, 0.f, 0.f, 0.f};
    bf16x8 At[4][2], B0[2][2], B1[2][2];
    const char* cA = (const char*)g.A + (size_t)cur.pm * tstep; const char* cB = (const char*)g.Bt + (size_t)cur.pn * tstep;
    S.a_ready(cur);
    if constexpr (SP2) {
        PG8_STAGE(PG8_SB(0, 0), cB, voffB); PG8_STAGE(PG8_SB(0, 1), cB + hstep, voffB); PG8_STAGE(PG8_SA(0, 0), cA, voffA); PG8_STAGE(PG8_SA(0, 1), cA + hstep, voffA);
        if (wr == 1) PG8_BAR;
        PG8_WAIT_V(2); PG8_BAR;
        PG8_STAGE(PG8_SB(1, 0), cB + kstep, voffB); PG8_STAGE(PG8_SA(1, 0), cA + kstep, voffA); PG8_STAGE(PG8_SB(1, 1), cB + hstep + kstep, voffB);
        PG8_WAIT_V(6); PG8_BAR;
    } else {
        PG8_STAGE(PG8_SB(0, 0), cB, voffB); PG8_STAGE(PG8_SA(0, 0), cA, voffA); PG8_STAGE(PG8_SB(0, 1), cB + hstep, voffB); PG8_STAGE(PG8_SA(0, 1), cA + hstep, voffA);
        if (wr == 1) PG8_BAR;
        PG8_WAIT_V(4); PG8_BAR;
        PG8_STAGE(PG8_SB(1, 0), cB + kstep, voffB); PG8_STAGE(PG8_SA(1, 0), cA + kstep, voffA); PG8_STAGE(PG8_SB(1, 1), cB + hstep + kstep, voffB);
        PG8_WAIT_V(6); PG8_BAR;
    }
    for (;;) {
        const bool has_next = S.next(ui + 1, nxt);
        const char* nA = has_next ? (const char*)g.A + (size_t)nxt.pm * tstep : cA; const char* nB = has_next ? (const char*)g.Bt + (size_t)nxt.pn * tstep : cB;
        for (int t = 0; t < nt; t += 2) {
            const bool last = (t == nt - 2);
            const char* a1 = cA + (size_t)(t + 1) * kstep;
            const char* a2 = last ? nA : cA + (size_t)(t + 2) * kstep; const char* b2 = last ? nB : cB + (size_t)(t + 2) * kstep;
            const char* a3 = a2 + kstep; const char* b3 = b2 + kstep;
            if (last && has_next) S.a_ready(nxt);
            if constexpr (SP2) {
            PG8_LDB(B0, 0, 0); PG8_LDB(B1, 0, 1); PG8_SCHED; PG8_LDA(At, 0, 0); PG8_STAGE(PG8_SA(1, 1), a1 + hstep, voffA);
            PG8_WAIT_V(8); PG8_WAIT_L(0); PG8_BAR; PG8_MMA(0, 0, At, B0); PG8_MMA(0, 1, At, B1); PG8_BAR; PG8_SCHED;
            PG8_LDA(At, 0, 1); PG8_STAGE(PG8_SB(0, 0), b2, voffB); PG8_STAGE(PG8_SB(0, 1), b2 + hstep, voffB); PG8_STAGE(PG8_SA(0, 0), a2, voffA);
            PG8_WAIT_V(8); PG8_WAIT_L(0); PG8_BAR; PG8_MMA(1, 0, At, B0); PG8_MMA(1, 1, At, B1); PG8_BAR; PG8_SCHED;
            PG8_LDB(B0, 1, 0); PG8_LDB(B1, 1, 1); PG8_SCHED; PG8_LDA(At, 1, 0); PG8_STAGE(PG8_SA(0, 1), a2 + hstep, voffA);
            PG8_WAIT_V(8); PG8_WAIT_L(0); PG8_BAR; PG8_MMA(0, 0, At, B0); PG8_MMA(0, 1, At, B1); PG8_BAR; PG8_SCHED;
            PG8_LDA(At, 1, 1); PG8_STAGE(PG8_SB(1, 0), b3, voffB); PG8_STAGE(PG8_SB(1, 1), b3 + hstep, voffB); PG8_STAGE(PG8_SA(1, 0), a3, voffA);
            PG8_WAIT_V(8); PG8_WAIT_L(0); PG8_BAR; PG8_MMA(1, 0, At, B0); PG8_MMA(1, 1, At, B1); PG8_BAR; PG8_SCHED;
            } else {
            PG8_LDB(B0, 0, 0); PG8_SCHED; PG8_LDA(At, 0, 0); PG8_STAGE(PG8_SA(1, 1), a1 + hstep, voffA);
            PG8_WAIT_L(8); PG8_BAR; PG8_WAIT_L(0); PG8_MMA(0, 0, At, B0); PG8_BAR; PG8_SCHED;
            PG8_LDB(B1, 0, 1); PG8_STAGE(PG8_SB(0, 0), b2, voffB);
            PG8_BAR; PG8_WAIT_L(0); PG8_MMA(0, 1, At, B1); PG8_BAR;
            PG8_LDA(At, 0, 1); PG8_STAGE(PG8_SA(0, 0), a2, voffA);
            PG8_BAR; PG8_WAIT_L(0); PG8_MMA(1, 0, At, B0); PG8_BAR; PG8_SCHED;
            PG8_STAGE(PG8_SB(0, 1), b2 + hstep, voffB);
            PG8_WAIT_V(6); PG8_BAR; PG8_MMA(1, 1, At, B1); PG8_BAR;
            PG8_LDB(B0, 1, 0); PG8_SCHED; PG8_LDA(At, 1, 0); PG8_STAGE(PG8_SA(0, 1), a2 + hstep, voffA);
            PG8_WAIT_L(8); PG8_BAR; PG8_WAIT_L(0); PG8_MMA(0, 0, At, B0); PG8_BAR; PG8_SCHED;
            PG8_LDB(B1, 1, 1); PG8_STAGE(PG8_SB(1, 0), b3, voffB);
            PG8_BAR; PG8_WAIT_L(0); PG8_MMA(0, 1, At, B1); PG8_BAR;
            PG8_LDA(At, 1, 1); PG8_STAGE(PG8_SA(1, 0), a3, voffA);
            PG8_BAR; PG8_WAIT_L(0); PG8_MMA(1, 0, At, B0); PG8_BAR; PG8_SCHED;
            PG8_STAGE(PG8_SB(1, 1), b3 + hstep, voffB);
            PG8_WAIT_V(6); PG8_BAR; PG8_MMA(1, 1, At, B1); PG8_BAR;
            }
        }
        if constexpr (ALIGN_EPI) { if (wr == 0) PG8_BAR; }
        E(acc, cur, wr, wc, fr, fq);
        if (!has_next) break;
        if (E.zero_after(cur)) {
#pragma unroll
        for (int a = 0; a < 2; ++a)
#pragma unroll
            for (int b = 0; b < 2; ++b)
#pragma unroll
                for (int m = 0; m < 4; ++m)
#pragma unroll
                    for (int n = 0; n < 2; ++n) acc[a][b][m][n] = (f32x4){0.f, 0.f, 0.f, 0.f};
        }
        cur = nxt; cA = nA; cB = nB; ++ui;
        if constexpr (ALIGN_EPI) { if (wr == 1) PG8_BAR; }
    }
    PG8_WAIT_V(0);
    if constexpr (!ALIGN_EPI) { if (wr == 0) PG8_BAR; }
    PG8_BAR;

#undef PG8_SA
#undef PG8_SB
#undef PG8_STAGE
#undef PG8_LDA
#undef PG8_LDB
#undef PG8_MMA
#undef PG8_WAIT_V
#undef PG8_WAIT_L
#undef PG8_BAR
#undef PG8_SCHED
}
}

constexpr int D = 1024, MP = 8192, M = 10240, NZ = 7168, DFF = 2816, NUP = 5632, NMOD = 6144;
constexpr int ZQ = 0, ZFF = 512, ZI = 1536, ZG = 2048, ZU = 2560, ZV = 3072, ZP = 3584;
constexpr float EPS = 1e-6f;
constexpr size_t MiB = 1u << 20;
constexpr size_t WS_BAR = 512 * 1024, WS_MOD = 0, WS_WIN = 1 * MiB, WS_WBR = 15 * MiB, WS_WOUT = 18 * MiB, WS_WUP = 20 * MiB, WS_WDN = 31 * MiB, WS_H = 37 * MiB, WS_Z = 57 * MiB, WS_O3 = 197 * MiB, WS_END = 252 * MiB;
constexpr size_t WS_SL = WS_O3 + 30 * MiB, WS_QC = WS_O3 + 34 * MiB, WS_AS = WS_O3 + 38 * MiB;
constexpr int LDS_BYTES = 147456;
constexpr int NPHASE = 22;

struct Args {
    const float *x_prompt, *x_sample, *c, *state, *c_ctx, *norm_mix, *norm_ffn, *w_ada, *b_ada, *w_in, *lb_logits, *hg_norm, *w_br_hg, *w_br_sg, *w_br_pool, *w_out,
        *sg_norm, *sg_w, *sg_b, *pool_w, *pool_scale, *ffn_up, *conv_w, *conv_b, *ffn_down, *final_norm;
    float* out; unsigned char* ws; int ph_lo, ph_hi;
};

__device__ __forceinline__ void transpose_item(const float* W, int K, int N, bf16* WT, LAS float* scr, int item, int lane) {
    const int nblk = N / 32, kb = item / nblk, nb = item % nblk, k0 = 64 * kb, n0 = 32 * nb;
    float wv[32];
#pragma unroll
    for (int i = 0; i < 32; ++i) wv[i] = W[(size_t)(k0 + 2 * i + (lane >> 5)) * N + n0 + (lane & 31)];
#pragma unroll
    for (int i = 0; i < 32; ++i) scr[(2 * i + (lane >> 5)) * 33 + (lane & 31)] = wv[i];
    asm volatile("s_waitcnt lgkmcnt(0)" ::: "memory");
    const int c = lane & 7;
#pragma unroll
    for (int j = 0; j < 4; ++j) { const int n = (lane >> 3) + 8 * j; const LAS float* s = scr + (8 * c) * 33 + n;
        u32x4 o; o.x = pk2(s[0 * 33], s[1 * 33]); o.y = pk2(s[2 * 33], s[3 * 33]); o.z = pk2(s[4 * 33], s[5 * 33]); o.w = pk2(s[6 * 33], s[7 * 33]);
        *(u32x4*)(WT + (size_t)(n0 + n) * K + k0 + 8 * c) = o; }
    asm volatile("s_waitcnt lgkmcnt(0)" ::: "memory");
}
__device__ __forceinline__ void convert_set(const Args& a, LAS unsigned char* lds, int l, int mask, int wid, int nw) {
    const int lane = TIDX & 63, wave = TIDX >> 6;
    LAS float* scr = (LAS float*)(lds + wave * 16384);
    unsigned char* ws = a.ws;
    const int I_IN = (mask & 1) ? (D / 64) * (NZ / 32) : 0, I_B0 = (mask & 2) ? (512 / 64) * (D / 32) : 0, I_B1 = (mask & 4) ? (512 / 64) * (D / 32) : 0, I_B2 = (mask & 8) ? (512 / 64) * (D / 32) : 0;
    const int I_OUT = (mask & 16) ? (D / 64) * (D / 32) : 0, I_UP = (mask & 32) ? (D / 64) * (NUP / 32) : 0, I_DN = (mask & 64) ? (DFF / 64) * (D / 32) : 0;
    const int NITEMS = I_IN + I_B0 + I_B1 + I_B2 + I_OUT + I_UP + I_DN;
    for (int it = wid; it < NITEMS; it += nw) {
        int r = it;
        if (r < I_IN) { transpose_item(a.w_in + (size_t)l * D * NZ, D, NZ, (bf16*)(ws + WS_WIN), scr, r, lane); continue; } r -= I_IN;
        if (r < I_B0) { transpose_item(a.w_br_hg + (size_t)l * 512 * D, 512, D, (bf16*)(ws + WS_WBR), scr, r, lane); continue; } r -= I_B0;
        if (r < I_B1) { transpose_item(a.w_br_sg + (size_t)l * 512 * D, 512, D, (bf16*)(ws + WS_WBR) + 1024 * 512, scr, r, lane); continue; } r -= I_B1;
        if (r < I_B2) { transpose_item(a.w_br_pool + (size_t)l * 512 * D, 512, D, (bf16*)(ws + WS_WBR) + 2 * 1024 * 512, scr, r, lane); continue; } r -= I_B2;
        if (r < I_OUT) { transpose_item(a.w_out + (size_t)l * D * D, D, D, (bf16*)(ws + WS_WOUT), scr, r, lane); continue; } r -= I_OUT;
        if (r < I_UP) { transpose_item(a.ffn_up + (size_t)l * D * NUP, D, NUP, (bf16*)(ws + WS_WUP), scr, r, lane); continue; } r -= I_UP;
        transpose_item(a.ffn_down + (size_t)l * DFF * D, DFF, D, (bf16*)(ws + WS_WDN), scr, r, lane);
    }
}
__device__ __forceinline__ void phase_mods(const Args& a, LAS unsigned char* lds) {
    const int tid = TIDX;
    LAS float* sc = (LAS float*)lds;
    LAS float* red = (LAS float*)(lds + 12288);
    float* mods = (float*)(a.ws + WS_MOD);
    for (int blk = blockIdx.x; blk < 256; blk += gridDim.x) {
        const int l = blk >> 7, n0 = (blk & 127) * 48;
        for (int i = tid; i < 3072; i += 512) { const int r = i >> 10, k = i & 1023; const float v = r == 0 ? a.c_ctx[k] : a.c[(r - 1) * 1024 + k]; sc[i] = silu_f(v); }
        __syncthreads();
        const int ks = tid / 12, c4 = tid - ks * 12;
        if (ks < 42) {
            const float* W = a.w_ada + (size_t)l * D * NMOD + n0 + 4 * c4;
            f32x4 a0 = (f32x4){0.f, 0.f, 0.f, 0.f}, a1 = a0, a2 = a0;
#pragma unroll 5
            for (int k = ks; k < 1024; k += 42) { const f32x4 wv = *(const f32x4*)(W + (size_t)k * NMOD); a0 += wv * sc[k]; a1 += wv * sc[1024 + k]; a2 += wv * sc[2048 + k]; }
            *(LAS f32x4*)(red + (ks * 3 + 0) * 48 + 4 * c4) = a0; *(LAS f32x4*)(red + (ks * 3 + 1) * 48 + 4 * c4) = a1; *(LAS f32x4*)(red + (ks * 3 + 2) * 48 + 4 * c4) = a2;
        }
        __syncthreads();
        if (tid < 144) { const int r = tid / 48, cc = tid - r * 48; float sm = 0.f;
            for (int w = 0; w < 42; ++w) sm += red[(w * 3 + r) * 48 + cc];
            mods[(l * 3 + r) * NMOD + n0 + cc] = sm + a.b_ada[l * NMOD + n0 + cc]; }
        __syncthreads();
    }
}
__device__ __forceinline__ void phase_norm(const Args& a, int l, const float* gain, int shift_off, bool first) {
    const int lane = TIDX & 63, wave = TIDX >> 6;
    const int gw = blockIdx.x * 8 + wave, NGW = gridDim.x * 8;
    const float* mods = (const float*)(a.ws + WS_MOD) + (size_t)l * 3 * NMOD;
    bf16* H = (bf16*)(a.ws + WS_H);
    f32x4 gn[4];
#pragma unroll
    for (int j = 0; j < 4; ++j) gn[j] = *(const f32x4*)(gain + 4 * (lane + 64 * j));
    for (int row = gw; row < M; row += NGW) {
        const int modrow = row < MP ? 0 : 1 + ((row - MP) >> 10);
        const float* src = first ? (row < MP ? a.x_prompt + (size_t)row * D : a.x_sample + (size_t)(row - MP) * D) : a.out + (size_t)row * D;
        f32x4 v[4]; float s = 0.f;
#pragma unroll
        for (int j = 0; j < 4; ++j) v[j] = *(const f32x4*)(src + 4 * (lane + 64 * j));
        if (first) {
            if (row >= MP) {
                const int n = (row - MP) & 1023; const float pr = (float)(n >> 6), pc = (float)(n & 63);
#pragma unroll
                for (int e = 0; e < 4; ++e) { const float om = expf(-(float)(4 * lane + e) * (9.210340371976184f / 256.f));
                    v[0][e] += sinf(pr * om); v[1][e] += cosf(pr * om); v[2][e] += sinf(pc * om); v[3][e] += cosf(pc * om); }
            }
#pragma unroll
            for (int j = 0; j < 4; ++j) *(f32x4*)(a.out + (size_t)row * D + 4 * (lane + 64 * j)) = v[j];
        }
#pragma unroll
        for (int j = 0; j < 4; ++j) s += (v[j][0] * v[j][0] + v[j][1] * v[j][1]) + (v[j][2] * v[j][2] + v[j][3] * v[j][3]);
        const float rstd = rsqrtf(wave_sum(s) * (1.f / D) + EPS);
        const float* mr = mods + modrow * NMOD + shift_off;
#pragma unroll
        for (int j = 0; j < 4; ++j) { const int c0 = 4 * (lane + 64 * j);
            const f32x4 sh = *(const f32x4*)(mr + c0), scl = *(const f32x4*)(mr + 1024 + c0);
            const f32x4 y = v[j] * rstd * gn[j] * (scl + 1.f) + sh;
            u32x2 o; o.x = pk2(y[0], y[1]); o.y = pk2(y[2], y[3]);
            *(u32x2*)(H + (size_t)row * D + c0) = o; }
    }
}
__device__ __forceinline__ void phase_final(const Args& a) {
    const int lane = TIDX & 63, wave = TIDX >> 6;
    const int gw = blockIdx.x * 8 + wave, NGW = gridDim.x * 8;
    f32x4 gn[4];
#pragma unroll
    for (int j = 0; j < 4; ++j) gn[j] = *(const f32x4*)(a.final_norm + 4 * (lane + 64 * j));
    for (int row = gw; row < M; row += NGW) {
        float* xr = a.out + (size_t)row * D;
        f32x4 v[4]; float s = 0.f;
#pragma unroll
        for (int j = 0; j < 4; ++j) { v[j] = *(const f32x4*)(xr + 4 * (lane + 64 * j)); s += (v[j][0] * v[j][0] + v[j][1] * v[j][1]) + (v[j][2] * v[j][2] + v[j][3] * v[j][3]); }
        const float rstd = rsqrtf(wave_sum(s) * (1.f / D) + EPS);
#pragma unroll
        for (int j = 0; j < 4; ++j) *(f32x4*)(xr + 4 * (lane + 64 * j)) = v[j] * rstd * gn[j];
    }
}

constexpr int SC_QT = 0, SC_KT = 4352, SC_QD = 8704, SC_KE = 13056, SC_VT = 18176, SC_AD = 23296, SC_BUF = 23808, SC_TOT = 2 * SC_BUF;
__device__ __forceinline__ s16x4 pack4(f32x4 v) { u32x2 p; p.x = pk2(v[0], v[1]); p.y = pk2(v[2], v[3]); return __builtin_bit_cast(s16x4, p); }
__device__ __forceinline__ void scan_item(const Args& a, LAS unsigned char* lds, int l, int s, int h, int d, int seg) {
    const int tid = TIDX, lane = tid & 63, w = tid >> 6, fr = lane & 15, fq = lane >> 4;
    const int k = (w & 1) * 64 + lane, tg = w >> 1;
    const int T = s < 32 ? 256 : 1024, base = s < 32 ? s * 256 : MP + (s - 32) * 1024, nch = 16, pos0 = 256 * seg;
    const bf16* Z = (const bf16*)(a.ws + WS_Z);
    bf16* OH = (bf16*)(a.ws + WS_H) + (size_t)d * M * 512;
    const int sidx = (((s - 32) * 4 + h) * 2 + d) * 4 + seg;
    bf16* QC = (bf16*)(a.ws + WS_QC) + (size_t)((((s - 32) * 4 + h) * 2 + d) * 1024) * 128;
    float run = 1.f;
    float lb = 0.f;
    if (l == 1) lb = sigm(a.lb_logits[(2 + d) * 512 + h * 128 + k] - a.lb_logits[d * 512 + h * 128 + k]);
    const float oml = 1.f - lb;
    f32x4 S[8];
    if (s >= 32 && seg == 0) { const float* st = a.state + ((((size_t)(s - 32) * 2 + l) * 2 + d) * 4 + h) * 16384;
#pragma unroll
        for (int r = 0; r < 8; ++r)
#pragma unroll
            for (int i = 0; i < 4; ++i) S[r][i] = st[(16 * r + 4 * fq + i) * 128 + 16 * w + fr];
    } else {
#pragma unroll
        for (int r = 0; r < 8; ++r) S[r] = (f32x4){0.f, 0.f, 0.f, 0.f};
    }
    LAS float* TOT = (LAS float*)(lds + SC_TOT);
    const int zcol_q = ZQ + h * 128 + k, zcol_f = ZFF + d * 512 + h * 128 + k, zcol_i = ZI + h * 128 + k;
    unsigned short nq[4], nf[4], ni[4];
#define SC_TOK(c, j) (d == 0 ? pos0 + 16 * (c) + (j) : T - 1 - pos0 - 16 * (c) - (j))
#define SC_ROW(c, j) (base + SC_TOK(c, j))
#define SC_BAR() do { asm volatile("s_waitcnt lgkmcnt(0)" ::: "memory"); __builtin_amdgcn_s_barrier(); asm volatile("" ::: "memory"); } while (0)
#pragma unroll
    for (int e = 0; e < 4; ++e) { const size_t ro = (size_t)SC_ROW(0, 4 * tg + e) * NZ; nq[e] = Z[ro + zcol_q]; nf[e] = Z[ro + zcol_f]; ni[e] = Z[ro + zcol_i]; }
    {
      for (int c = 0; c < nch; ++c) {
        float q[4], kk[4], pf[4], vv[4];
#pragma unroll
        for (int e = 0; e < 4; ++e) {
            const float zf = fmaxf(bf2f(nf[e]), -30.f), ex = __expf(-zf), sg = frcp(1.f + ex);
            pf[e] = lb + oml * sg; kk[e] = oml * ex * sg; q[e] = bf2f(nq[e]); vv[e] = bf2f(ni[e]);
        }
        if (c + 1 < nch) {
#pragma unroll
            for (int e = 0; e < 4; ++e) { const size_t ro = (size_t)SC_ROW(c + 1, 4 * tg + e) * NZ; nq[e] = Z[ro + zcol_q]; nf[e] = Z[ro + zcol_f]; ni[e] = Z[ro + zcol_i]; }
        }
        pf[1] *= pf[0]; pf[2] *= pf[1]; pf[3] *= pf[2];
        TOT[tg * 128 + k] = pf[3];
        SC_BAR();
        const float t0 = TOT[k], t1 = TOT[128 + k], t2 = TOT[256 + k], t3 = TOT[384 + k];
        const float off = (tg > 0 ? t0 : 1.f) * (tg > 1 ? t1 : 1.f) * (tg > 2 ? t2 : 1.f), pref = t0 * t1, p15 = pref * (t2 * t3);
        const float ipref = frcp(fmaxf(pref, 1e-30f));
        LAS unsigned char* B = lds + (c & 1) * SC_BUF;
        float ke[4];
#pragma unroll
        for (int e = 0; e < 4; ++e) { const float P = off * pf[e], iP = frcp(fmaxf(P, 1e-30f)); const int j = 4 * tg + e;
            const unsigned w0 = pk2(q[e] * (P * ipref), kk[e] * (pref * iP)), w1 = pk2(q[e] * P, 0.f);
            ((LAS bf16*)(B + SC_QT))[j * 136 + k] = (bf16)(w0 & 0xffffu);
            ((LAS bf16*)(B + SC_KT))[j * 136 + k] = (bf16)(w0 >> 16);
            ((LAS bf16*)(B + SC_QD))[j * 136 + k] = (bf16)(w1 & 0xffffu);
            if (s >= 32) QC[(size_t)SC_TOK(c, j) * 128 + k] = (bf16)(pk2(q[e] * P * run, 0.f) & 0xffffu);
            ke[e] = kk[e] * (p15 * iP); }
        run *= p15;
        { u32x2 p; p.x = pk2(ke[0], ke[1]); p.y = pk2(ke[2], ke[3]); *(LAS u32x2*)(B + SC_KE + k * 40 + tg * 8) = p;
          p.x = pk2(vv[0], vv[1]); p.y = pk2(vv[2], vv[3]); *(LAS u32x2*)(B + SC_VT + k * 40 + tg * 8) = p; }
        if (tg == 0) ((LAS float*)(B + SC_AD))[k] = p15;
        SC_BAR();
        f32x4 pt = (f32x4){0.f, 0.f, 0.f, 0.f};
#pragma unroll
        for (int k4 = 0; k4 < 4; ++k4) {
            const bf16x8 ka = *(const LAS bf16x8*)(B + SC_KT + fr * 272 + k4 * 64 + fq * 16);
            const bf16x8 qb = *(const LAS bf16x8*)(B + SC_QT + fr * 272 + k4 * 64 + fq * 16);
            pt = __builtin_amdgcn_mfma_f32_16x16x32_bf16(ka, qb, pt, 0, 0, 0);
        }
#pragma unroll
        for (int i = 0; i < 4; ++i) if (4 * fq + i > fr) pt[i] = 0.f;
        const s16x4 pa = pack4(pt);
        const s16x4 vb = *(const LAS s16x4*)(B + SC_VT + (16 * w + fr) * 40 + fq * 8);
        f32x4 o = __builtin_amdgcn_mfma_f32_16x16x16bf16_1k(pa, vb, (f32x4){0.f, 0.f, 0.f, 0.f}, 0, 0, 0);
#pragma unroll
        for (int r = 0; r < 8; ++r) {
            const s16x4 qa = *(const LAS s16x4*)(B + SC_QD + fr * 272 + r * 32 + fq * 8);
            o = __builtin_amdgcn_mfma_f32_16x16x16bf16_1k(qa, pack4(S[r]), o, 0, 0, 0);
        }
#pragma unroll
        for (int r = 0; r < 8; ++r) {
            const f32x4 ad = *(const LAS f32x4*)(B + SC_AD + (16 * r + 4 * fq) * 4);
            const s16x4 ka = *(const LAS s16x4*)(B + SC_KE + (16 * r + fr) * 40 + fq * 8);
            S[r] = __builtin_amdgcn_mfma_f32_16x16x16bf16_1k(ka, vb, S[r] * ad, 0, 0, 0);
        }
#pragma unroll
        for (int i = 0; i < 4; ++i) OH[(size_t)SC_ROW(c, 4 * fq + i) * 512 + h * 128 + 16 * w + fr] = (bf16)(pk2(o[i], 0.f) & 0xffffu);
      }
    }
#undef SC_ROW
#undef SC_TOK
#undef SC_BAR
    if (s >= 32) { float* sl = (float*)(a.ws + WS_SL) + (size_t)sidx * 16384;
#pragma unroll
        for (int r = 0; r < 8; ++r)
#pragma unroll
            for (int i = 0; i < 4; ++i) sl[(16 * r + 4 * fq + i) * 128 + 16 * w + fr] = S[r][i];
        if (tg == 0) ((float*)(a.ws + WS_AS))[sidx * 128 + k] = run; }
    if (s < 32) { float* st = a.out + (size_t)M * D + ((((size_t)s * 2 + l) * 2 + d) * 4 + h) * 16384;
#pragma unroll
        for (int r = 0; r < 8; ++r)
#pragma unroll
            for (int i = 0; i < 4; ++i) st[(16 * r + 4 * fq + i) * 128 + 16 * w + fr] = S[r][i]; }
    __syncthreads();
}
__device__ __forceinline__ void mm128(const LAS bf16* As, const LAS bf16* Bs, f32x4 (&acc)[2][4], int wr, int wc, int fr, int fq, bool zero = true) {
    if (zero) {
#pragma unroll
    for (int mt = 0; mt < 2; ++mt)
#pragma unroll
        for (int nt = 0; nt < 4; ++nt) acc[mt][nt] = (f32x4){0.f, 0.f, 0.f, 0.f}; }
#pragma unroll
    for (int k4 = 0; k4 < 4; ++k4) {
        bf16x8 af[2];
#pragma unroll
        for (int mt = 0; mt < 2; ++mt) af[mt] = *(const LAS bf16x8*)(As + (32 * wr + 16 * mt + fr) * 136 + 32 * k4 + 8 * fq);
#pragma unroll
        for (int nt = 0; nt < 4; ++nt) {
            const bf16x8 bfr = *(const LAS bf16x8*)(Bs + (64 * wc + 16 * nt + fr) * 136 + 32 * k4 + 8 * fq);
#pragma unroll
            for (int mt = 0; mt < 2; ++mt) acc[mt][nt] = __builtin_amdgcn_mfma_f32_16x16x32_bf16(af[mt], bfr, acc[mt][nt], 0, 0, 0);
        }
    }
}
__device__ __forceinline__ void stage_f32_tile(const float* W, LAS bf16* T) {
#pragma unroll
    for (int it = 0; it < 8; ++it) { const int idx = TIDX * 4 + 2048 * it, r = idx >> 7, cc = idx & 127;
        const f32x4 v = *(const f32x4*)(W + idx); u32x2 o; o.x = pk2(v[0], v[1]); o.y = pk2(v[2], v[3]); *(LAS u32x2*)(T + r * 136 + cc) = o; }
}
__device__ __forceinline__ void stage_f32_tile_T(const float* W, LAS bf16* T) {
#pragma unroll
    for (int it = 0; it < 4; ++it) { const int p = TIDX + 512 * it, n = p & 127, k0 = (p >> 7) * 8;
        float v[8];
#pragma unroll
        for (int e = 0; e < 8; ++e) v[e] = W[(size_t)(k0 + e) * 128 + n];
        u32x4 o; o.x = pk2(v[0], v[1]); o.y = pk2(v[2], v[3]); o.z = pk2(v[4], v[5]); o.w = pk2(v[6], v[7]);
        *(LAS u32x4*)(T + n * 136 + k0) = o; }
}
__device__ __forceinline__ void sg_item(const Args& a, LAS unsigned char* lds, int l, int ci) {
    const int tid = TIDX, lane = tid & 63, w = tid >> 6, fr = lane & 15, fq = lane >> 4, wr = w >> 1, wc = w & 1;
    const int r0 = ci * 128;
    const bf16* Z = (const bf16*)(a.ws + WS_Z);
    bf16* O = (bf16*)(a.ws + WS_O3) + (size_t)M * 512;
    LAS bf16* As = (LAS bf16*)lds; LAS bf16* Bs = (LAS bf16*)(lds + 34816); LAS float* rstd = (LAS float*)(lds + 69632);
    { u32x4 zz[16];
#pragma unroll
      for (int rr = 0; rr < 16; ++rr) zz[rr] = *(const u32x4*)(Z + (size_t)(r0 + 16 * w + rr) * NZ + ZV + 8 * lane);
#pragma unroll
      for (int rr = 0; rr < 16; ++rr) { float ss = 0.f;
#pragma unroll
        for (int e = 0; e < 4; ++e) { const float g0 = bflo(zz[rr][e]), g1 = bfhi(zz[rr][e]); ss += g0 * g0 + g1 * g1; }
        ss = wave_sum(ss); if (lane == 0) rstd[16 * w + rr] = rsqrtf(ss * (1.f / 512.f) + EPS); } }
    __syncthreads();
    for (int g = 0; g < 4; ++g) {
        stage_f32_tile(a.sg_w + ((size_t)l * 4 + g) * 16384, As);
#pragma unroll
        for (int it = 0; it < 4; ++it) { const int p = tid + 512 * it, c = p & 127, s0 = (p >> 7) * 8;
            const float gn = a.sg_norm[l * 512 + g * 128 + c];
            float v[8];
#pragma unroll
            for (int e = 0; e < 8; ++e) v[e] = bf2f(Z[(size_t)(r0 + s0 + e) * NZ + ZV + g * 128 + c]) * rstd[s0 + e] * gn;
            u32x4 o; o.x = pk2(v[0], v[1]); o.y = pk2(v[2], v[3]); o.z = pk2(v[4], v[5]); o.w = pk2(v[6], v[7]);
            *(LAS u32x4*)(Bs + c * 136 + s0) = o; }
        __syncthreads();
        f32x4 acc[2][4]; mm128(As, Bs, acc, wr, wc, fr, fq);
        { unsigned short uu[2][4][4]; float bias[2][4];
#pragma unroll
          for (int mt = 0; mt < 2; ++mt)
#pragma unroll
            for (int i = 0; i < 4; ++i) { const int row = 32 * wr + 16 * mt + 4 * fq + i; bias[mt][i] = a.sg_b[(l * 4 + g) * 128 + row];
#pragma unroll
                for (int nt = 0; nt < 4; ++nt) uu[mt][i][nt] = Z[(size_t)(r0 + row) * NZ + ZU + g * 128 + 64 * wc + 16 * nt + fr]; }
#pragma unroll
          for (int mt = 0; mt < 2; ++mt)
#pragma unroll
            for (int i = 0; i < 4; ++i) { const int row = 32 * wr + 16 * mt + 4 * fq + i;
#pragma unroll
                for (int nt = 0; nt < 4; ++nt) { const int col = g * 128 + 64 * wc + 16 * nt + fr;
                    O[(size_t)(r0 + row) * 512 + col] = (bf16)(pk2(bf2f(uu[mt][i][nt]) * (acc[mt][nt][i] + bias[mt][i]), 0.f) & 0xffffu); } } }
        __syncthreads();
    }
}
__device__ __forceinline__ void pool_item(const Args& a, LAS unsigned char* lds, int l, int ci) {
    const int tid = TIDX, lane = tid & 63, w = tid >> 6, fr = lane & 15, fq = lane >> 4, wr = w >> 1, wc = w & 1;
    const int r0 = ci * 128;
    const int T = r0 < MP ? 256 : 1024, base = r0 < MP ? (r0 & ~255) : MP + ((r0 - MP) & ~1023), t0 = r0 - base;
    const bf16* Z = (const bf16*)(a.ws + WS_Z);
    bf16* O = (bf16*)(a.ws + WS_O3) + (size_t)2 * M * 512;
    LAS bf16* As = (LAS bf16*)lds; LAS bf16* Bs = (LAS bf16*)(lds + 34816); LAS bf16* Ts = (LAS bf16*)(lds + 69632);
    const int c = tid & 127, seg = tid >> 7;
    for (int g = 0; g < 4; ++g) {
        const int hw = 1 << g;
        stage_f32_tile_T(a.pool_w + ((size_t)l * 4 + g) * 16384, Bs);
#pragma unroll
        for (int it = 0; it < 5; ++it) { const int ch = tid + 512 * it;
            if (ch < 2304) { const int rr = ch >> 4, c8 = (ch & 15) * 8, tau = t0 - 8 + rr;
                u32x4 v = (u32x4){0u, 0u, 0u, 0u};
                if (tau >= 0 && tau < T) v = *(const u32x4*)(Z + (size_t)(base + tau) * NZ + ZP + g * 128 + c8);
                *(LAS u32x4*)(Ts + rr * 136 + c8) = v; } }
        __syncthreads();
        {
            const int ts = t0 + 32 * seg;
            const LAS bf16* tp = Ts + (32 * seg + 8) * 136 + c;
            float sum = 0.f;
            for (int dd = -hw; dd < hw; ++dd) sum += bf2f(tp[dd * 136]);
#pragma unroll 8
            for (int tt = 0; tt < 32; ++tt) { const int t = ts + tt;
                const int lo = t - hw < 0 ? 0 : t - hw, hi = t + hw > T ? T : t + hw;
                const float cur = bf2f(tp[tt * 136]);
                As[(32 * seg + tt) * 136 + c] = (bf16)(pk2(sum * frcp((float)(hi - lo)) - cur, 0.f) & 0xffffu);
                sum += bf2f(tp[(tt + hw) * 136]) - bf2f(tp[(tt - hw) * 136]); }
        }
        __syncthreads();
        f32x4 acc[2][4]; mm128(As, Bs, acc, wr, wc, fr, fq);
#pragma unroll
        for (int nt = 0; nt < 4; ++nt) { const int col = g * 128 + 64 * wc + 16 * nt + fr; const float sc = a.pool_scale[l * 512 + col];
#pragma unroll
            for (int mt = 0; mt < 2; ++mt)
#pragma unroll
                for (int i = 0; i < 4; ++i) { const int row = 32 * wr + 16 * mt + 4 * fq + i; O[(size_t)(r0 + row) * 512 + col] = (bf16)(pk2(acc[mt][nt][i] * sc, 0.f) & 0xffffu); } }
        __syncthreads();
    }
}
__device__ __forceinline__ void phase_mixers(const Args& a, LAS unsigned char* lds, int l) {
    for (int it = blockIdx.x; it < 480; it += (int)gridDim.x) {
        if (it < 256) { for (int rp = 0; rp <= ((REPMASK >> 10) & 1); ++rp) scan_item(a, lds, l, it >> 3, (it >> 1) & 3, it & 1, 0); }
        else if (it < 320) { const int p = it - 256; for (int rp = 0; rp <= ((REPMASK >> 10) & 1); ++rp) scan_item(a, lds, l, 32 + (p >> 5), (p >> 3) & 3, (p >> 2) & 1, p & 3); }
        else if (it < 400) { for (int rp = 0; rp <= ((REPMASK >> 11) & 1); ++rp) sg_item(a, lds, l, it - 320); }
        else { for (int rp = 0; rp <= ((REPMASK >> 12) & 1); ++rp) pool_item(a, lds, l, it - 400); }
    }
    for (int rp = 0; rp < ((REPMASK >> 13) & 1); ++rp) convert_set(a, lds, l, l == 0 ? 0x7e : 0x40, (int)blockIdx.x * 8 + (TIDX >> 6), (int)gridDim.x * 8);
    if (l == 0) convert_set(a, lds, 0, 0x1e, (int)blockIdx.x * 8 + (TIDX >> 6), (int)gridDim.x * 8);
}
__device__ __forceinline__ void phase_combine(const Args& a, int l, int bidx, int nblk) {
    const int lane = TIDX & 63, wave = TIDX >> 6;
    const int gw = bidx * 8 + wave, NGW = nblk * 8;
    const bf16* Z = (const bf16*)(a.ws + WS_Z); const bf16* OF = (const bf16*)(a.ws + WS_H); const bf16* OB = OF + (size_t)M * 512;
    bf16* O = (bf16*)(a.ws + WS_O3);
    const int c8 = 8 * lane;
    const f32x4 g0 = *(const f32x4*)(a.hg_norm + l * 128 + (c8 & 127)), g1 = *(const f32x4*)(a.hg_norm + l * 128 + (c8 & 127) + 4);
    for (int row = gw; row < MP; row += NGW) {
        const u32x4 f = *(const u32x4*)(OF + (size_t)row * 512 + c8), bb = *(const u32x4*)(OB + (size_t)row * 512 + c8), zg = *(const u32x4*)(Z + (size_t)row * NZ + ZG + c8);
        float v[8], ss = 0.f;
#pragma unroll
        for (int e = 0; e < 4; ++e) { v[2 * e] = bflo(f[e]) + bflo(bb[e]); v[2 * e + 1] = bfhi(f[e]) + bfhi(bb[e]); ss += v[2 * e] * v[2 * e] + v[2 * e + 1] * v[2 * e + 1]; }
        ss += __shfl_xor(ss, 1); ss += __shfl_xor(ss, 2); ss += __shfl_xor(ss, 4); ss += __shfl_xor(ss, 8);
        const float r = rsqrtf(ss * (1.f / 128.f) + EPS);
        u32x4 o;
        o.x = pk2(v[0] * r * g0[0] * bflo(zg.x), v[1] * r * g0[1] * bfhi(zg.x));
        o.y = pk2(v[2] * r * g0[2] * bflo(zg.y), v[3] * r * g0[3] * bfhi(zg.y));
        o.z = pk2(v[4] * r * g1[0] * bflo(zg.z), v[5] * r * g1[1] * bfhi(zg.z));
        o.w = pk2(v[6] * r * g1[2] * bflo(zg.w), v[7] * r * g1[3] * bfhi(zg.w));
        *(u32x4*)(O + (size_t)row * 512 + c8) = o;
    }
}
__device__ __forceinline__ void sample_combine_item(const Args& a, LAS unsigned char* lds, int l, int sq, int tseg, int h, int hf0) {
    const int tid = TIDX, lane = tid & 63, w = tid >> 6, fr = lane & 15, fq = lane >> 4, wr = w >> 1, wc = w & 1;
    LAS bf16* As = (LAS bf16*)lds; LAS bf16* Bs = (LAS bf16*)(lds + 34816); LAS float* Ct = (LAS float*)lds;
    const bf16* Z = (const bf16*)(a.ws + WS_Z); const bf16* OF = (const bf16*)(a.ws + WS_H); const bf16* OB = OF + (size_t)M * 512;
    bf16* O = (bf16*)(a.ws + WS_O3);
    const float* SL = (const float*)(a.ws + WS_SL); const float* AS = (const float*)(a.ws + WS_AS);
    const int hf = hf0;
    f32x4 acc[2][4];
#pragma unroll
    for (int mt = 0; mt < 2; ++mt)
#pragma unroll
        for (int nt = 0; nt < 4; ++nt) acc[mt][nt] = (f32x4){0.f, 0.f, 0.f, 0.f};
    for (int d = 0; d < 2; ++d) {
        const int g = d == 0 ? tseg : 3 - tseg;
        if (g == 0) continue;
        const int ib = ((sq * 4 + h) * 2 + d) * 4;
#pragma unroll
        for (int it = 0; it < 4; ++it) { const int p = tid + 512 * it, v = p & 127, k0 = (p >> 7) * 8;
            float E[8];
#pragma unroll
            for (int e = 0; e < 8; ++e) E[e] = SL[(size_t)ib * 16384 + (k0 + e) * 128 + v];
            for (int gg = 1; gg < g; ++gg) {
#pragma unroll
                for (int e = 0; e < 8; ++e) E[e] = E[e] * AS[(ib + gg) * 128 + k0 + e] + SL[(size_t)(ib + gg) * 16384 + (k0 + e) * 128 + v]; }
            u32x4 o; o.x = pk2(E[0], E[1]); o.y = pk2(E[2], E[3]); o.z = pk2(E[4], E[5]); o.w = pk2(E[6], E[7]);
            *(LAS u32x4*)(Bs + v * 136 + k0) = o; }
        const bf16* QC = (const bf16*)(a.ws + WS_QC) + (size_t)(((sq * 4 + h) * 2 + d) * 1024 + 256 * tseg) * 128;
        {
#pragma unroll
            for (int it = 0; it < 4; ++it) { const int ch = tid + 512 * it, r = ch >> 4, c8 = (ch & 15) * 8;
                *(LAS u32x4*)(As + r * 136 + c8) = *(const u32x4*)(QC + (size_t)(128 * hf + r) * 128 + c8); }
            __syncthreads();
            mm128(As, Bs, acc, wr, wc, fr, fq, false);
            __syncthreads();
        }
    }
    const float gn0 = a.hg_norm[l * 128 + 2 * lane], gn1 = a.hg_norm[l * 128 + 2 * lane + 1];
    {
#pragma unroll
        for (int mt = 0; mt < 2; ++mt)
#pragma unroll
            for (int nt = 0; nt < 4; ++nt)
#pragma unroll
                for (int i = 0; i < 4; ++i) Ct[(32 * wr + 16 * mt + 4 * fq + i) * 132 + 64 * wc + 16 * nt + fr] = acc[mt][nt][i];
        __syncthreads();
        { unsigned pf_[16], pb_[16], zg[16];
          const int grow0 = MP + sq * 1024 + 256 * tseg + 128 * hf + 16 * w;
#pragma unroll
          for (int rr = 0; rr < 16; ++rr) { const size_t go = (size_t)(grow0 + rr) * 512 + h * 128 + 2 * lane;
              pf_[rr] = *(const unsigned*)(OF + go); pb_[rr] = *(const unsigned*)(OB + go); zg[rr] = *(const unsigned*)(Z + (size_t)(grow0 + rr) * NZ + ZG + h * 128 + 2 * lane); }
#pragma unroll
          for (int rr = 0; rr < 16; ++rr) { const int r = 16 * w + rr; const size_t go = (size_t)(grow0 + rr) * 512 + h * 128 + 2 * lane;
              const float v0 = Ct[r * 132 + 2 * lane] + bflo(pf_[rr]) + bflo(pb_[rr]), v1 = Ct[r * 132 + 2 * lane + 1] + bfhi(pf_[rr]) + bfhi(pb_[rr]);
              const float rs = rsqrtf(wave_sum(v0 * v0 + v1 * v1) * (1.f / 128.f) + EPS);
              *(unsigned*)(O + go) = pk2(v0 * rs * gn0 * bflo(zg[rr]), v1 * rs * gn1 * bfhi(zg[rr])); } }
        __syncthreads();
    }
}
__device__ __forceinline__ void phase_conv(const Args& a, int l) {
    const bf16* HF = (const bf16*)(a.ws + WS_Z); bf16* ACT = (bf16*)(a.ws + WS_O3);
    const float* cw = a.conv_w + (size_t)l * 3 * NUP; const float* cb = a.conv_b + (size_t)l * NUP;
    const int total = (M / 8) * 352;
    for (int idx = blockIdx.x * 512 + TIDX; idx < total; idx += (int)gridDim.x * 512) {
        const int run = idx / 352, j0 = (idx - run * 352) * 8, row0 = run * 8;
        const int t0 = row0 < MP ? (row0 & 255) : ((row0 - MP) & 1023), T = row0 < MP ? 256 : 1024;
        float r[2][8][8];
#pragma unroll
        for (int hf = 0; hf < 2; ++hf) { const int col = hf * DFF + j0; const bf16* hp0 = HF + (size_t)row0 * NUP + col;
            u32x4 h[10];
#pragma unroll
            for (int q = 0; q < 10; ++q) { const int t = t0 - 1 + q; h[q] = (t >= 0 && t < T) ? *(const u32x4*)(hp0 + (ptrdiff_t)(q - 1) * NUP) : (u32x4){0u, 0u, 0u, 0u}; }
            const f32x4 wa0 = *(const f32x4*)(cw + col), wa1 = *(const f32x4*)(cw + col + 4), wb0 = *(const f32x4*)(cw + NUP + col), wb1 = *(const f32x4*)(cw + NUP + col + 4);
            const f32x4 wc0 = *(const f32x4*)(cw + 2 * NUP + col), wc1 = *(const f32x4*)(cw + 2 * NUP + col + 4), bi0 = *(const f32x4*)(cb + col), bi1 = *(const f32x4*)(cb + col + 4);
#pragma unroll
            for (int e = 0; e < 4; ++e) {
                const float w0l = e < 2 ? wa0[2 * e] : wa1[2 * e - 4], w0h = e < 2 ? wa0[2 * e + 1] : wa1[2 * e - 3];
                const float w1l = e < 2 ? wb0[2 * e] : wb1[2 * e - 4], w1h = e < 2 ? wb0[2 * e + 1] : wb1[2 * e - 3];
                const float w2l = e < 2 ? wc0[2 * e] : wc1[2 * e - 4], w2h = e < 2 ? wc0[2 * e + 1] : wc1[2 * e - 3];
                const float bl = e < 2 ? bi0[2 * e] : bi1[2 * e - 4], bh = e < 2 ? bi0[2 * e + 1] : bi1[2 * e - 3];
#pragma unroll
                for (int q = 0; q < 8; ++q) {
                    r[hf][q][2 * e] = w0l * bflo(h[q][e]) + w1l * bflo(h[q + 1][e]) + w2l * bflo(h[q + 2][e]) + bl;
                    r[hf][q][2 * e + 1] = w0h * bfhi(h[q][e]) + w1h * bfhi(h[q + 1][e]) + w2h * bfhi(h[q + 2][e]) + bh; } } }
#pragma unroll
        for (int q = 0; q < 8; ++q) { u32x4 o;
            o.x = pk2(silu_f(r[0][q][0]) * r[1][q][0], silu_f(r[0][q][1]) * r[1][q][1]); o.y = pk2(silu_f(r[0][q][2]) * r[1][q][2], silu_f(r[0][q][3]) * r[1][q][3]);
            o.z = pk2(silu_f(r[0][q][4]) * r[1][q][4], silu_f(r[0][q][5]) * r[1][q][5]); o.w = pk2(silu_f(r[0][q][6]) * r[1][q][6], silu_f(r[0][q][7]) * r[1][q][7]);
            *(u32x4*)(ACT + (size_t)(row0 + q) * DFF + j0) = o; }
    }
}

#define XB_TMO      128
#define XB_XCNT(j)  (256  + 64 * (j))
#define XB_XSUB(j)  (1280 + 64 * (j))
#define XB_XGEN(j)  (2304 + 64 * (j))
#define XB_TOP      3328
#define XB_TOPGEN   3392
#define XCD_BAR_WORDS 3456
#define XB_SPIN_CAP (1u << 18)

__device__ __forceinline__ unsigned xb_ld(unsigned* p)              { return __hip_atomic_load(p, __ATOMIC_RELAXED, __HIP_MEMORY_SCOPE_AGENT); }
__device__ __forceinline__ unsigned xb_add(unsigned* p, unsigned v) { return __hip_atomic_fetch_add(p, v, __ATOMIC_RELAXED, __HIP_MEMORY_SCOPE_AGENT); }
__device__ __forceinline__ unsigned xb_xcc_id() { return (unsigned)__builtin_amdgcn_s_getreg((3 << 11) | 20) & 0xFu; }
#define XB_SPIN(cond, bar) do { unsigned _sp = 0; while (cond) { __builtin_amdgcn_s_sleep(1); \
    if ((++_sp & 255u) == 0u) { if (xb_ld(&(bar)[XB_TMO])) break; if (_sp > XB_SPIN_CAP) { atomicAdd(&(bar)[XB_TMO], 1u); break; } } } } while (0)

struct XcdBarrier {
    unsigned* bar; unsigned x;
    volatile LAS unsigned* st;
};

__device__ __forceinline__ XcdBarrier xcd_barrier_post(unsigned* bar, volatile LAS unsigned* st) {
    XcdBarrier b; b.bar = bar; b.x = xb_xcc_id(); b.st = st;
    if (threadIdx.x == 0) (void)xb_add(&bar[XB_XCNT(b.x)], 1u);
    return b;
}
__device__ __forceinline__ void xcd_barrier_complete(unsigned* bar, unsigned x, unsigned& nloc, unsigned& nx) {
    const unsigned G = gridDim.x * gridDim.y * gridDim.z;
    unsigned sum, cnt, mine, sp = 0u;
    for (;;) {
        sum = 0u; cnt = 0u; mine = 0u;
#pragma unroll
        for (unsigned j = 0; j < 16; ++j) { const unsigned c = xb_ld(&bar[XB_XCNT(j)]); sum += c; cnt += (c > 0u) ? 1u : 0u; mine = (j == x) ? c : mine; }
        if (sum == G) break;
        __builtin_amdgcn_s_sleep(1);
        if ((++sp & 255u) == 0u) { if (xb_ld(&bar[XB_TMO])) break; if (sp > XB_SPIN_CAP) { atomicAdd(&bar[XB_TMO], 1u); break; } }
    }
    nloc = mine > 0u ? mine : 1u; nx = cnt > 0u ? cnt : 1u;
}

__device__ __forceinline__ void xcd_barrier(const XcdBarrier& b) {
    asm volatile("s_waitcnt vmcnt(0)" ::: "memory");
    __syncthreads();
    if (threadIdx.x == 0) {
        unsigned* bar = b.bar;
        __builtin_amdgcn_s_waitcnt(0);
        unsigned nloc = b.st[0], nx = b.st[1];
        if (nloc == 0u) { xcd_barrier_complete(bar, b.x, nloc, nx); b.st[0] = nloc; b.st[1] = nx; }
        const unsigned old = xb_add(&bar[XB_XSUB(b.x)], 1u);
        const unsigned gen = old / nloc;
        if (old + 1u == (gen + 1u) * nloc) {
            __builtin_amdgcn_fence(__ATOMIC_RELEASE, "agent");
            asm volatile("s_waitcnt vmcnt(0)" ::: "memory");
            const unsigned og = xb_add(&bar[XB_TOP], 1u);
            const unsigned tg = og / nx;
            if (og + 1u == (tg + 1u) * nx) xb_add(&bar[XB_TOPGEN], 1u);
            else XB_SPIN(xb_ld(&bar[XB_TOPGEN]) == tg, bar);
            __builtin_amdgcn_fence(__ATOMIC_ACQUIRE, "agent");
            xb_add(&bar[XB_XGEN(b.x)], 1u);
            asm volatile("s_waitcnt vmcnt(0)" ::: "memory");
        } else {
            XB_SPIN(xb_ld(&bar[XB_XGEN(b.x)]) == gen, bar);
            __builtin_amdgcn_fence(__ATOMIC_ACQUIRE, "agent");
            asm volatile("s_waitcnt vmcnt(0)" ::: "memory");
        }
    }
    __syncthreads();
}

__global__ void __launch_bounds__(512, 2) fwd_kernel(Args a) {
    extern __shared__ __attribute__((aligned(16))) unsigned char lds_raw[];
    LAS unsigned char* lds = (LAS unsigned char*)lds_raw;
    cg::grid_group grid = cg::this_grid();
    unsigned char* ws = a.ws;
    const int G = gridDim.x, bid = blockIdx.x;
    if (threadIdx.x < 4) ((volatile LAS unsigned*)(lds + 131072 + 64))[threadIdx.x] = 0u;
    __syncthreads();
    const XcdBarrier bar = xcd_barrier_post((unsigned*)(a.ws + WS_BAR), (volatile LAS unsigned*)(lds + 131072 + 64));
    for (int ph = a.ph_lo; ph < a.ph_hi; ++ph) {
        if (ph == 0 && PHSEL(100)) { phase_mods(a, lds); convert_set(a, lds, 0, 1, bid * 8 + (TIDX >> 6), G * 8); }
        else if (ph == NPHASE - 1 && PHSEL(101)) { phase_final(a); }
        else {
            const int l = (ph - 1) / 10, sp = (ph - 1) % 10;
            for (int rep = 0; rep <= ((REPMASK >> sp) & 1); ++rep) {
            const float* mods = (const float*)(ws + WS_MOD) + (size_t)l * 3 * NMOD;
            if ((sp == 0 || sp == 6) && PHSEL(0)) { phase_norm(a, l, (sp == 0 ? a.norm_mix : a.norm_ffn) + l * D, sp == 0 ? 0 : 3 * D, sp == 0 && l == 0); }
            else if ((sp == 1 || sp == 7) && PHSEL(1)) {
                const bool up = sp == 7;
                pg8::Gemm g{(const bf16*)(ws + WS_H), (const bf16*)(ws + (up ? WS_WUP : WS_WIN)), M, up ? NUP : NZ, D}; pg8::StaticOrder S; S.init(M, up ? NUP : NZ, G, bid);
                pg8::EpiZ E{(bf16*)(ws + WS_Z), up ? NUP : NZ, up ? 1 : 0}; pg8::gemm_phase<pg8::EpiZ, pg8::StaticOrder, true, true>(lds, g, S, E); }
            else if (sp == 2 && PHSEL(2)) { phase_mixers(a, lds, l); }
            else if (sp == 3 && PHSEL(3)) { if (bid < 64) sample_combine_item(a, lds, l, bid >> 5, (bid >> 3) & 3, (bid >> 1) & 3, bid & 1); else phase_combine(a, l, bid - 64, G - 64); }
            else if (sp == 4 && PHSEL(4)) { pg8::Gemm g{(const bf16*)(ws + WS_O3), (const bf16*)(ws + WS_WBR), M, D, 512}; pg8::TileOrder S{bid, 3};
                pg8::EpiBranch E{(const bf16*)(ws + WS_Z), (bf16*)(ws + WS_H)}; pg8::gemm_phase<pg8::EpiBranch, pg8::TileOrder, true, true>(lds, g, S, E);
                if ((bid >> 3) >= 20) convert_set(a, lds, l, l == 0 ? 0x60 : 0x40, ((bid >> 3) - 20) * 64 + (bid & 7) * 8 + (TIDX >> 6), 12 * 64); }
            else if ((sp == 5 || sp == 9) && PHSEL(5)) {
                const bool dn = sp == 9;
                pg8::Gemm g{(const bf16*)(ws + (dn ? WS_O3 : WS_H)), (const bf16*)(ws + (dn ? WS_WDN : WS_WOUT)), M, D, dn ? DFF : D}; pg8::TileOrder S{bid, 1};
                pg8::EpiResid E{a.out, mods + (dn ? 5 * D : 2 * D)}; pg8::gemm_phase<pg8::EpiResid, pg8::TileOrder, true, true>(lds, g, S, E);
                if (dn && l == 0 && (bid >> 3) >= 20) convert_set(a, lds, 1, 0x3f, ((bid >> 3) - 20) * 64 + (bid & 7) * 8 + (TIDX >> 6), 12 * 64); }
            else if (sp == 8 && PHSEL(8)) { phase_conv(a, l); }
            }
        }
        if (ph + 1 < a.ph_hi) { if (a.ph_hi > 1000) grid.sync(); else xcd_barrier(bar); }
    }
}

extern "C" void kernel_launch(void* const* d_in, const int* in_sizes, int n_in, void* d_out, int out_size, void* d_ws, size_t ws_size, hipStream_t stream) {
    static int grid = 0;
    if (grid == 0) {
        if (n_in != 26 || ws_size < WS_END) { fprintf(stderr, "kernel_launch: expected 26 inputs and >= %zu bytes of workspace (got %d, %zu)\n", (size_t)WS_END, n_in, ws_size); grid = -1; return; }
        int dev = 0, cus = 0, per_cu = 0;
        hipGetDevice(&dev); hipDeviceGetAttribute(&cus, hipDeviceAttributeMultiprocessorCount, dev);
        if (hipFuncSetAttribute((const void*)fwd_kernel, hipFuncAttributeMaxDynamicSharedMemorySize, LDS_BYTES) != hipSuccess) { fprintf(stderr, "kernel_launch: hipFuncSetAttribute failed\n"); grid = -1; return; }
        hipOccupancyMaxActiveBlocksPerMultiprocessor(&per_cu, (const void*)fwd_kernel, 512, LDS_BYTES);
        if (per_cu < 1) { fprintf(stderr, "kernel_launch: occupancy query says %d blocks per CU\n", per_cu); per_cu = 1; }
        (void)hipGetLastError();
        grid = cus;
    }
    if (grid < 0) return;
    if (hipMemsetAsync((char*)d_ws + WS_BAR, 0, 16384, stream) != hipSuccess) { fprintf(stderr, "kernel_launch: memset failed\n"); return; }
    Args a{};
    const float** p = (const float**)&a;
    for (int i = 0; i < 26; ++i) p[i] = (const float*)d_in[i];
    a.out = (float*)d_out; a.ws = (unsigned char*)d_ws;
#if MK_SPLIT
    for (int ph = 0; ph < NPHASE; ++ph) { a.ph_lo = ph; a.ph_hi = ph + 1; hipLaunchKernelGGL(fwd_kernel, dim3(grid), dim3(512), LDS_BYTES, stream, a); }
#else
    a.ph_lo = 0; a.ph_hi = NPHASE;
    void* args[] = {&a};
    hipError_t e = hipLaunchCooperativeKernel((const void*)fwd_kernel, dim3(grid), dim3(512), args, LDS_BYTES, stream);
    if (e != hipSuccess) fprintf(stderr, "cooperative launch failed: %s (grid %d)\n", hipGetErrorString(e), grid);
#endif
}
```

```cpp
#include <hip/hip_runtime.h>
#include <hip/hip_cooperative_groups.h>
#include <cstdio>
#include <cstdint>
namespace cg = cooperative_groups;

#ifndef MK_SPLIT
#define MK_SPLIT 0
#endif

#ifndef REPMASK
#define REPMASK 0
#endif
#ifndef PHSEL
#define PHSEL(x) true
#endif
#define LAS __attribute__((address_space(3)))
__device__ __forceinline__ int opaque_tid() { int t = (int)threadIdx.x; asm volatile("" : "+v"(t)); return t; }
#define TIDX opaque_tid()
typedef unsigned short bf16;
typedef float f32x4 __attribute__((ext_vector_type(4)));
typedef short bf16x8 __attribute__((ext_vector_type(8)));
typedef short s16x4 __attribute__((ext_vector_type(4)));
typedef unsigned u32x4 __attribute__((ext_vector_type(4)));
typedef unsigned u32x2 __attribute__((ext_vector_type(2)));

__device__ __forceinline__ float bf2f(unsigned v) { return __uint_as_float(v << 16); }
__device__ __forceinline__ float bflo(unsigned w) { return __uint_as_float(w << 16); }
__device__ __forceinline__ float bfhi(unsigned w) { return __uint_as_float(w & 0xffff0000u); }
__device__ __forceinline__ unsigned f2bf(float f) { unsigned u = __float_as_uint(f); return (u + 0x7fffu + ((u >> 16) & 1u)) >> 16; }
typedef float f32x2_t __attribute__((ext_vector_type(2))); typedef __bf16 bf16x2_t __attribute__((ext_vector_type(2)));
__device__ __forceinline__ unsigned pk2(float lo, float hi) { f32x2_t v = {lo, hi}; bf16x2_t b = __builtin_convertvector(v, bf16x2_t); return __builtin_bit_cast(unsigned, b); }
__device__ __forceinline__ float frcp(float x) { return __builtin_amdgcn_rcpf(x); }
__device__ __forceinline__ float sigm(float x) { return frcp(1.f + __expf(-x)); }
__device__ __forceinline__ float silu_f(float x) { return x * sigm(x); }
__device__ __forceinline__ float gelu_f(float x) { return x * sigm(1.5957691216057308f * (x + 0.044715f * x * x * x)); }
__device__ __forceinline__ float wave_sum(float v) {
#pragma unroll
    for (int o = 1; o < 64; o <<= 1) v += __shfl_xor(v, o);
    return v;
}

namespace pg8 {
#define PG8_LAS __attribute__((address_space(3)))
typedef unsigned short bf16_t;
constexpr int BM = 256, BK = 64, HALF = 128, HTB = HALF * BK * 2, STAGE_BYTES = 8 * HTB, NXCD = 8, WGM = 8;
__host__ __device__ __forceinline__ int lds_byte(int r, int c) { const int st = (r >> 4) * 2 + (c >> 5), rr = r & 15, cc = c & 31, ob = rr * 64 + cc * 2; return st * 1024 + (ob ^ (((ob >> 9) & 1) << 5)); }
__host__ __device__ __forceinline__ void stage_rc(int b, int& R, int& C) { const int st = b / 1024, sb = b % 1024, swz = sb ^ (((sb >> 9) & 1) << 5); R = (st >> 1) * 16 + swz / 64; C = (st & 1) * 32 + (swz % 64) / 2; }
__host__ __device__ __forceinline__ int perm32(int rho) { const int n = rho >> 4, i = rho & 15; return 8 * (i >> 2) + 4 * n + (i & 3); }
struct Unit { int pm, pn; };
struct Gemm { const bf16_t* A; const bf16_t* Bt; int M, N, K; };
struct StaticOrder {
    int nM, nN, nwg, G, c;
    __host__ __device__ void init(int M, int N, int G_, int c_) { nM = M / BM; nN = N / BM; nwg = nM * nN; G = G_; c = c_; }
    __host__ __device__ bool next(int i, Unit& u) const {
        const long L = (long)i * G + c; if (L >= nwg) return false;
        int wgid = (int)L; { const int q = nwg / NXCD, r = nwg % NXCD, xcd = wgid % NXCD, off = wgid / NXCD; wgid = (xcd < r ? xcd * (q + 1) : r * (q + 1) + (xcd - r) * q) + off; }
        const int nig = WGM * nN, gid = wgid / nig, fm = gid * WGM, gsz = (nM - fm) < WGM ? (nM - fm) : WGM;
        u.pm = fm + ((wgid % nig) % gsz); u.pn = (wgid % nig) / gsz; return true;
    }
    __device__ __forceinline__ void a_ready(const Unit&) const {}
    __device__ __forceinline__ void done(const Unit&) const {}
};
struct TileOrder {
    int c, nch;
    __device__ bool next(int i, Unit& u) const {
        const int xcd = c & 7, slot = c >> 3; if (slot >= 20 || i >= nch) return false;
        const int L = xcd * 20 + slot; u.pm = i * 40 + (L >> 2); u.pn = i * 4 + (L & 3); return true;
    }
    __device__ __forceinline__ void a_ready(const Unit&) const {}
    __device__ __forceinline__ void done(const Unit&) const {}
};
__device__ __forceinline__ unsigned cvt_pk_bf16(float lo, float hi) { return pk2(lo, hi); }

struct EpiStore {
    static constexpr bool PERM = true, AFTER_DRAIN = false;
    bf16_t* O; int ldc;
    __device__ __forceinline__ bool zero_after(const Unit&) const { return true; }
    __device__ __forceinline__ void operator()(f32x4 (&acc)[2][2][4][2], const Unit& u, int wr, int wc, int fr, int fq) const {
        const int row0 = u.pm * BM + wr * 64 + fr, col0 = u.pn * BM + wc * 32 + 8 * fq;
#pragma unroll
        for (int ai = 0; ai < 2; ++ai)
#pragma unroll
            for (int m = 0; m < 4; ++m) { bf16_t* rowp = O + (size_t)(row0 + ai * HALF + m * 16) * ldc + col0;
#pragma unroll
                for (int bj = 0; bj < 2; ++bj) { const f32x4 v0 = acc[ai][bj][m][0], v1 = acc[ai][bj][m][1];
                    u32x4 w; w.x = cvt_pk_bf16(v0[0], v0[1]); w.y = cvt_pk_bf16(v0[2], v0[3]); w.z = cvt_pk_bf16(v1[0], v1[1]); w.w = cvt_pk_bf16(v1[2], v1[3]);
                    *(u32x4*)(rowp + bj * HALF) = w; } }
    }
};
struct EpiZ {
    static constexpr bool PERM = true, AFTER_DRAIN = false;
    bf16_t* O; int ldc; int plain;
    __device__ __forceinline__ bool zero_after(const Unit&) const { return true; }
    __device__ __forceinline__ void operator()(f32x4 (&acc)[2][2][4][2], const Unit& u, int wr, int wc, int fr, int fq) const {
        const int row0 = u.pm * BM + wr * 64 + fr, col0 = u.pn * BM + wc * 32 + 8 * fq;
        const int pn = u.pn;
        const int mode = plain ? 0 : pn < 2 ? 1 : (pn < 8 ? 0 : (pn < 10 ? 2 : (pn < 14 ? 3 : (pn < 16 ? 0 : 4))));
#pragma unroll
        for (int ai = 0; ai < 2; ++ai)
#pragma unroll
            for (int m = 0; m < 4; ++m) { bf16_t* rowp = O + (size_t)(row0 + ai * HALF + m * 16) * ldc + col0;
#pragma unroll
                for (int bj = 0; bj < 2; ++bj) { float v[8];
#pragma unroll
                    for (int e = 0; e < 4; ++e) { v[e] = acc[ai][bj][m][0][e]; v[4 + e] = acc[ai][bj][m][1][e]; }
                    if (mode == 1) {
#pragma unroll
                        for (int e = 0; e < 8; ++e) v[e] = v[e] * sigm(v[e]) * 0.08838834764831845f;
                    } else if (mode == 2) {
#pragma unroll
                        for (int e = 0; e < 8; ++e) v[e] = v[e] * sigm(v[e]);
                    } else if (mode == 3) {
#pragma unroll
                        for (int e = 0; e < 8; ++e) v[e] = gelu_f(v[e]);
                    } else if (mode == 4) {
#pragma unroll
                        for (int e = 0; e < 8; ++e) v[e] = sigm(v[e]);
                    }
                    u32x4 w; w.x = cvt_pk_bf16(v[0], v[1]); w.y = cvt_pk_bf16(v[2], v[3]); w.z = cvt_pk_bf16(v[4], v[5]); w.w = cvt_pk_bf16(v[6], v[7]);
                    *(u32x4*)(rowp + bj * HALF) = w; } }
    }
};
struct EpiResid {
    static constexpr bool PERM = true, AFTER_DRAIN = false;
    float* X; const float* gate;
    __device__ __forceinline__ bool zero_after(const Unit&) const { return true; }
    __device__ __forceinline__ void operator()(f32x4 (&acc)[2][2][4][2], const Unit& u, int wr, int wc, int fr, int fq) const {
        const int modrow = u.pm < 32 ? 0 : 1 + ((u.pm - 32) >> 2);
        const int row0 = u.pm * BM + wr * 64 + fr, col0 = u.pn * BM + wc * 32 + 8 * fq;
        const float* g = gate + modrow * 6144 + col0;
        f32x4 gv[2][2];
#pragma unroll
        for (int bj = 0; bj < 2; ++bj) { gv[bj][0] = *(const f32x4*)(g + bj * HALF); gv[bj][1] = *(const f32x4*)(g + bj * HALF + 4); }
#pragma unroll
        for (int ai = 0; ai < 2; ++ai) {
            f32x4 xv[4][2][2];
#pragma unroll
            for (int m = 0; m < 4; ++m) { const float* rowp = X + (size_t)(row0 + ai * HALF + m * 16) * 1024 + col0;
#pragma unroll
                for (int bj = 0; bj < 2; ++bj) { xv[m][bj][0] = *(const f32x4*)(rowp + bj * HALF); xv[m][bj][1] = *(const f32x4*)(rowp + bj * HALF + 4); } }
#pragma unroll
            for (int m = 0; m < 4; ++m) { float* rowp = X + (size_t)(row0 + ai * HALF + m * 16) * 1024 + col0;
#pragma unroll
                for (int bj = 0; bj < 2; ++bj) {
                    *(f32x4*)(rowp + bj * HALF) = xv[m][bj][0] + gv[bj][0] * acc[ai][bj][m][0]; *(f32x4*)(rowp + bj * HALF + 4) = xv[m][bj][1] + gv[bj][1] * acc[ai][bj][m][1]; } }
            asm volatile("" ::: "memory"); }
    }
};
struct EpiBranch {
    static constexpr bool PERM = true, AFTER_DRAIN = false;
    const bf16_t* Z; bf16_t* O;
    __device__ __forceinline__ bool zero_after(const Unit& u) const { return u.pm >= 80; }
    __device__ __forceinline__ void operator()(f32x4 (&acc)[2][2][4][2], const Unit& u, int wr, int wc, int fr, int fq) const {
        const int br = u.pm / 40, pm = u.pm - br * 40, pn = u.pn - br * 4;
        const int row0 = pm * BM + wr * 64 + fr, col0 = pn * BM + wc * 32 + 8 * fq;
#pragma unroll
        for (int ai = 0; ai < 2; ++ai) {
            u32x4 gcv[4][2], gnv[4][2];
#pragma unroll
            for (int m = 0; m < 4; ++m)
#pragma unroll
                for (int bj = 0; bj < 2; ++bj) { const bf16_t* zq_ = Z + (size_t)(row0 + ai * HALF + m * 16) * 7168 + 4096 + br * 1024 + col0 + bj * HALF;
                    gcv[m][bj] = *(const u32x4*)zq_; gnv[m][bj] = br < 2 ? *(const u32x4*)(zq_ + 1024) : (u32x4){0u, 0u, 0u, 0u}; }
#pragma unroll
            for (int m = 0; m < 4; ++m) { const int row = row0 + ai * HALF + m * 16;
#pragma unroll
                for (int bj = 0; bj < 2; ++bj) {
                    const bf16_t* zp = Z + (size_t)row * 7168 + 4096 + br * 1024 + col0 + bj * HALF;
                    const u32x4 gc = gcv[m][bj];
                    float f[8];
                    if (br < 2) { const u32x4 gn = gnv[m][bj];
#pragma unroll
                        for (int e = 0; e < 4; ++e) { f[2 * e] = bflo(gc[e]) * frcp(fmaxf(bflo(gn[e]), 1e-20f)); f[2 * e + 1] = bfhi(gc[e]) * frcp(fmaxf(bfhi(gn[e]), 1e-20f)); }
                    } else {
#pragma unroll
                        for (int e = 0; e < 4; ++e) { f[2 * e] = bflo(gc[e]); f[2 * e + 1] = bfhi(gc[e]); }
                    }
                    f32x4 v0 = acc[ai][bj][m][0], v1 = acc[ai][bj][m][1];
                    v0[0] *= f[0]; v0[1] *= f[1]; v0[2] *= f[2]; v0[3] *= f[3]; v1[0] *= f[4]; v1[1] *= f[5]; v1[2] *= f[6]; v1[3] *= f[7];
                    if (br < 2) { acc[ai][bj][m][0] = v0; acc[ai][bj][m][1] = v1; }
                    else { u32x4 w; w.x = cvt_pk_bf16(v0[0], v0[1]); w.y = cvt_pk_bf16(v0[2], v0[3]); w.z = cvt_pk_bf16(v1[0], v1[1]); w.w = cvt_pk_bf16(v1[2], v1[3]);
                        *(u32x4*)(O + (size_t)row * 1024 + col0 + bj * HALF) = w; }
                } } }
    }
};

template <class Epi, class Sched, bool ALIGN_EPI = false, bool SP2 = false>
__device__ __forceinline__ void gemm_phase(PG8_LAS unsigned char* lds, const Gemm g, const Sched& S, const Epi& E) {
    const int tid = TIDX, wid = __builtin_amdgcn_readfirstlane(tid >> 6), lane = tid & 63, wr = wid >> 2, wc = wid & 3, fr = lane & 15, fq = lane >> 4;
    const int K = g.K, nt = K / BK;
    unsigned voffA[2], voffB[2];
#pragma unroll
    for (int i = 0; i < 2; ++i) { int R, C; stage_rc(tid * 16 + i * 8192, R, C); const int Rb = Epi::PERM ? ((R & ~31) + perm32(R & 31)) : R;
        voffA[i] = (unsigned)(R * K + C) * 2u; voffB[i] = (unsigned)(Rb * K + C) * 2u; }
    const size_t kstep = (size_t)(BK * 2);
    const size_t hstep = (size_t)HALF * K * 2;
    const size_t tstep = 2 * hstep;
    const unsigned ldsw = (unsigned)wid * 1024u;
    const int aoff = lds_byte(wr * 64 + fr, fq * 8), boff = lds_byte(wc * 32 + fr, fq * 8);
#define PG8_SA(b, h) (((b) * 2 + (h)) * HTB)
#define PG8_SB(b, h) ((4 + (b) * 2 + (h)) * HTB)
#define PG8_STAGE(bufoff, gbase, voff) do { _Pragma("unroll") for (int _i = 0; _i < 2; ++_i) \
        __builtin_amdgcn_global_load_lds((const unsigned*)((const char*)(gbase) + (voff)[_i]), (PG8_LAS unsigned*)(lds + (bufoff) + ldsw + _i * 8192), 16, 0, 0); } while (0)
#define PG8_LDA(dst, b, h) do { _Pragma("unroll") for (int m = 0; m < 4; ++m) _Pragma("unroll") for (int k = 0; k < 2; ++k) dst[m][k] = *(const PG8_LAS bf16x8*)(lds + PG8_SA(b, h) + aoff + m * 2048 + k * 1024); } while (0)
#define PG8_LDB(dst, b, h) do { _Pragma("unroll") for (int n = 0; n < 2; ++n) _Pragma("unroll") for (int k = 0; k < 2; ++k) dst[n][k] = *(const PG8_LAS bf16x8*)(lds + PG8_SB(b, h) + boff + n * 2048 + k * 1024); } while (0)
#define PG8_MMA(ai, bj, At, Bt) do { __builtin_amdgcn_s_setprio(1); _Pragma("unroll") for (int m = 0; m < 4; ++m) _Pragma("unroll") for (int n = 0; n < 2; ++n) _Pragma("unroll") for (int k = 0; k < 2; ++k) \
        acc[ai][bj][m][n] = __builtin_amdgcn_mfma_f32_16x16x32_bf16(Bt[n][k], At[m][k], acc[ai][bj][m][n], 0, 0, 0); __builtin_amdgcn_s_setprio(0); } while (0)
#define PG8_WAIT_V(n) asm volatile("s_waitcnt vmcnt(" #n ")" ::: "memory")
#define PG8_WAIT_L(n) asm volatile("s_waitcnt lgkmcnt(" #n ")" ::: "memory")
#define PG8_BAR __builtin_amdgcn_s_barrier()
#define PG8_SCHED __builtin_amdgcn_sched_barrier(0)
    Unit cur, nxt; int ui = 0;
    if (!S.next(0, cur)) return;
    f32x4 acc[2][2][4][2];
#pragma unroll
    for (int a = 0; a < 2; ++a)
#pragma unroll
        for (int b = 0; b < 2; ++b)
#pragma unroll
            for (int m = 0; m < 4; ++m)
#pragma unroll
                for (int n = 0; n < 2; ++n) acc[a][b][m][n] = (f32x4){0.f, 0.f, 0.f, 0.f};
    bf16x8 At[4][2], B0[2][2], B1[2][2];
    const char* cA = (const char*)g.A + (size_t)cur.pm * tstep; const char* cB = (const char*)g.Bt + (size_t)cur.pn * tstep;
    S.a_ready(cur);
    if constexpr (SP2) {
        PG8_STAGE(PG8_SB(0, 0), cB, voffB); PG8_STAGE(PG8_SB(0, 1), cB + hstep, voffB); PG8_STAGE(PG8_SA(0, 0), cA, voffA); PG8_STAGE(PG8_SA(0, 1), cA + hstep, voffA);
        if (wr == 1) PG8_BAR;
        PG8_WAIT_V(2); PG8_BAR;
        PG8_STAGE(PG8_SB(1, 0), cB + kstep, voffB); PG8_STAGE(PG8_SA(1, 0), cA + kstep, voffA); PG8_STAGE(PG8_SB(1, 1), cB + hstep + kstep, voffB);
        PG8_WAIT_V(6); PG8_BAR;
    } else {
        PG8_STAGE(PG8_SB(0, 0), cB, voffB); PG8_STAGE(PG8_SA(0, 0), cA, voffA); PG8_STAGE(PG8_SB(0, 1), cB + hstep, voffB); PG8_STAGE(PG8_SA(0, 1), cA + hstep, voffA);
        if (wr == 1) PG8_BAR;
        PG8_WAIT_V(4); PG8_BAR;
        PG8_STAGE(PG8_SB(1, 0), cB + kstep, voffB); PG8_STAGE(PG8_SA(1, 0), cA + kstep, voffA); PG8_STAGE(PG8_SB(1, 1), cB + hstep + kstep, voffB);
        PG8_WAIT_V(6); PG8_BAR;
    }
    for (;;) {
        const bool has_next = S.next(ui + 1, nxt);
        const char* nA = has_next ? (const char*)g.A + (size_t)nxt.pm * tstep : cA; const char* nB = has_next ? (const char*)g.Bt + (size_t)nxt.pn * tstep : cB;
        for (int t = 0; t < nt; t += 2) {
            const bool last = (t == nt - 2);
            const char* a1 = cA + (size_t)(t + 1) * kstep;
            const char* a2 = last ? nA : cA + (size_t)(t + 2) * kstep; const char* b2 = last ? nB : cB + (size_t)(t + 2) * kstep;
            const char* a3 = a2 + kstep; const char* b3 = b2 + kstep;
            if (last && has_next) S.a_ready(nxt);
            if constexpr (SP2) {
            PG8_LDB(B0, 0, 0); PG8_LDB(B1, 0, 1); PG8_SCHED; PG8_LDA(At, 0, 0); PG8_STAGE(PG8_SA(1, 1), a1 + hstep, voffA);
            PG8_WAIT_V(8); PG8_WAIT_L(0); PG8_BAR; PG8_MMA(0, 0, At, B0); PG8_MMA(0, 1, At, B1); PG8_BAR; PG8_SCHED;
            PG8_LDA(At, 0, 1); PG8_STAGE(PG8_SB(0, 0), b2, voffB); PG8_STAGE(PG8_SB(0, 1), b2 + hstep, voffB); PG8_STAGE(PG8_SA(0, 0), a2, voffA);
            PG8_WAIT_V(8); PG8_WAIT_L(0); PG8_BAR; PG8_MMA(1, 0, At, B0); PG8_MMA(1, 1, At, B1); PG8_BAR; PG8_SCHED;
            PG8_LDB(B0, 1, 0); PG8_LDB(B1, 1, 1); PG8_SCHED; PG8_LDA(At, 1, 0); PG8_STAGE(PG8_SA(0, 1), a2 + hstep, voffA);
            PG8_WAIT_V(8); PG8_WAIT_L(0); PG8_BAR; PG8_MMA(0, 0, At, B0); PG8_MMA(0, 1, At, B1); PG8_BAR; PG8_SCHED;
            PG8_LDA(At, 1, 1); PG8_STAGE(PG8_SB(1, 0), b3, voffB); PG8_STAGE(PG8_SB(1, 1), b3 + hstep, voffB); PG8_STAGE(PG8_SA(1, 0), a3, voffA);
            PG8_WAIT_V(8); PG8_WAIT_L(0); PG8_BAR; PG8_MMA(1, 0, At, B0); PG8_MMA(1, 1, At, B1); PG8_BAR; PG8_SCHED;
            } else {
            PG8_LDB(B0, 0, 0); PG8_SCHED; PG8_LDA(At, 0, 0); PG8_STAGE(PG8_SA(1, 1), a1 + hstep, voffA);
            PG8_WAIT_L(8); PG8_BAR; PG8_WAIT_L(0); PG8_MMA(0, 0, At, B0); PG8_BAR; PG8_SCHED;
            PG8_LDB(B1, 0, 1); PG8_STAGE(PG8_SB(0, 0), b2, voffB);
            PG8_BAR; PG8_WAIT_L(0); PG8_MMA(0, 1, At, B1); PG8_BAR;
            PG8_LDA(At, 0, 1); PG8_STAGE(PG8_SA(0, 0), a2, voffA);
            PG8_BAR; PG8_WAIT_L(0); PG8_MMA(1, 0, At, B0); PG8_BAR; PG8_SCHED;
            PG8_STAGE(PG8_SB(0, 1), b2 + hstep, voffB);
            PG8_WAIT_V(6); PG8_BAR; PG8_MMA(1, 1, At, B1); PG8_BAR;
            PG8_LDB(B0, 1, 0); PG8_SCHED; PG8_LDA(At, 1, 0); PG8_STAGE(PG8_SA(0, 1), a2 + hstep, voffA);
            PG8_WAIT_L(8); PG8_BAR; PG8_WAIT_L(0); PG8_MMA(0, 0, At, B0); PG8_BAR; PG8_SCHED;
            PG8_LDB(B1, 1, 1); PG8_STAGE(PG8_SB(1, 0), b3, voffB);
            PG8_BAR; PG8_WAIT_L(0); PG8_MMA(0, 1, At, B1); PG8_BAR;
            PG8_LDA(At, 1, 1); PG8_STAGE(PG8_SA(1, 0), a3, voffA);
            PG8_BAR; PG8_WAIT_L(0); PG8_MMA(1, 0, At, B0); PG8_BAR; PG8_SCHED;
            PG8_STAGE(PG8_SB(1, 1), b3 + hstep, voffB);
            PG8_WAIT_V(6); PG8_BAR; PG8_MMA(1, 1, At, B1); PG8_BAR;
            }
        }
        if constexpr (ALIGN_EPI) { if (wr == 0) PG8_BAR; }
        E(acc, cur, wr, wc, fr, fq);
        if (!has_next) break;
        if (E.zero_after(cur)) {
#pragma unroll
        for (int a = 0; a < 2; ++a)
#pragma unroll
            for (int b = 0; b < 2; ++b)
#pragma unroll
                for (int m = 0; m < 4; ++m)
#pragma unroll
                    for (int n = 0; n < 2; ++n) acc[a][b][m][n] = (f32x4){0.f, 0.f, 0.f, 0.f};
        }
        cur = nxt; cA = nA; cB = nB; ++ui;
        if constexpr (ALIGN_EPI) { if (wr == 1) PG8_BAR; }
    }
    PG8_WAIT_V(0);
    if constexpr (!ALIGN_EPI) { if (wr == 0) PG8_BAR; }
    PG8_BAR;

#undef PG8_SA
#undef PG8_SB
#undef PG8_STAGE
#undef PG8_LDA
#undef PG8_LDB
#undef PG8_MMA
#undef PG8_WAIT_V
#undef PG8_WAIT_L
#undef PG8_BAR
#undef PG8_SCHED
}
}

constexpr int D = 1024, MP = 8192, M = 10240, NZ = 7168, DFF = 2816, NUP = 5632, NMOD = 6144;
constexpr int ZQ = 0, ZFF = 512, ZI = 1536, ZG = 2048, ZU = 2560, ZV = 3072, ZP = 3584;
constexpr float EPS = 1e-6f;
constexpr size_t MiB = 1u << 20;
constexpr size_t WS_BAR = 512 * 1024, WS_MOD = 0, WS_WIN = 1 * MiB, WS_WBR = 15 * MiB, WS_WOUT = 18 * MiB, WS_WUP = 20 * MiB, WS_WDN = 31 * MiB, WS_H = 37 * MiB, WS_Z = 57 * MiB, WS_O3 = 197 * MiB, WS_END = 252 * MiB;
constexpr size_t WS_SL = WS_O3 + 30 * MiB, WS_QC = WS_O3 + 34 * MiB, WS_AS = WS_O3 + 38 * MiB;
constexpr int LDS_BYTES = 147456;
constexpr int NPHASE = 22;

struct Args {
    const float *x_prompt, *x_sample, *c, *state, *c_ctx, *norm_mix, *norm_ffn, *w_ada, *b_ada, *w_in, *lb_logits, *hg_norm, *w_br_hg, *w_br_sg, *w_br_pool, *w_out,
        *sg_norm, *sg_w, *sg_b, *pool_w, *pool_scale, *ffn_up, *conv_w, *conv_b, *ffn_down, *final_norm;
    float* out; unsigned char* ws; int ph_lo, ph_hi;
};

__device__ __forceinline__ void transpose_item(const float* W, int K, int N, bf16* WT, LAS float* scr, int item, int lane) {
    const int nblk = N / 32, kb = item / nblk, nb = item % nblk, k0 = 64 * kb, n0 = 32 * nb;
    float wv[32];
#pragma unroll
    for (int i = 0; i < 32; ++i) wv[i] = W[(size_t)(k0 + 2 * i + (lane >> 5)) * N + n0 + (lane & 31)];
#pragma unroll
    for (int i = 0; i < 32; ++i) scr[(2 * i + (lane >> 5)) * 33 + (lane & 31)] = wv[i];
    asm volatile("s_waitcnt lgkmcnt(0)" ::: "memory");
    const int c = lane & 7;
#pragma unroll
    for (int j = 0; j < 4; ++j) { const int n = (lane >> 3) + 8 * j; const LAS float* s = scr + (8 * c) * 33 + n;
        u32x4 o; o.x = pk2(s[0 * 33], s[1 * 33]); o.y = pk2(s[2 * 33], s[3 * 33]); o.z = pk2(s[4 * 33], s[5 * 33]); o.w = pk2(s[6 * 33], s[7 * 33]);
        *(u32x4*)(WT + (size_t)(n0 + n) * K + k0 + 8 * c) = o; }
    asm volatile("s_waitcnt lgkmcnt(0)" ::: "memory");
}
__device__ __forceinline__ void convert_set(const Args& a, LAS unsigned char* lds, int l, int mask, int wid, int nw) {
    const int lane = TIDX & 63, wave = TIDX >> 6;
    LAS float* scr = (LAS float*)(lds + wave * 16384);
    unsigned char* ws = a.ws;
    const int I_IN = (mask & 1) ? (D / 64) * (NZ / 32) : 0, I_B0 = (mask & 2) ? (512 / 64) * (D / 32) : 0, I_B1 = (mask & 4) ? (512 / 64) * (D / 32) : 0, I_B2 = (mask & 8) ? (512 / 64) * (D / 32) : 0;
    const int I_OUT = (mask & 16) ? (D / 64) * (D / 32) : 0, I_UP = (mask & 32) ? (D / 64) * (NUP / 32) : 0, I_DN = (mask & 64) ? (DFF / 64) * (D / 32) : 0;
    const int NITEMS = I_IN + I_B0 + I_B1 + I_B2 + I_OUT + I_UP + I_DN;
    for (int it = wid; it < NITEMS; it += nw) {
        int r = it;
        if (r < I_IN) { transpose_item(a.w_in + (size_t)l * D * NZ, D, NZ, (bf16*)(ws + WS_WIN), scr, r, lane); continue; } r -= I_IN;
        if (r < I_B0) { transpose_item(a.w_br_hg + (size_t)l * 512 * D, 512, D, (bf16*)(ws + WS_WBR), scr, r, lane); continue; } r -= I_B0;
        if (r < I_B1) { transpose_item(a.w_br_sg + (size_t)l * 512 * D, 512, D, (bf16*)(ws + WS_WBR) + 1024 * 512, scr, r, lane); continue; } r -= I_B1;
        if (r < I_B2) { transpose_item(a.w_br_pool + (size_t)l * 512 * D, 512, D, (bf16*)(ws + WS_WBR) + 2 * 1024 * 512, scr, r, lane); continue; } r -= I_B2;
        if (r < I_OUT) { transpose_item(a.w_out + (size_t)l * D * D, D, D, (bf16*)(ws + WS_WOUT), scr, r, lane); continue; } r -= I_OUT;
        if (r < I_UP) { transpose_item(a.ffn_up + (size_t)l * D * NUP, D, NUP, (bf16*)(ws + WS_WUP), scr, r, lane); continue; } r -= I_UP;
        transpose_item(a.ffn_down + (size_t)l * DFF * D, DFF, D, (bf16*)(ws + WS_WDN), scr, r, lane);
    }
}
__device__ __forceinline__ void phase_mods(const Args& a, LAS unsigned char* lds) {
    const int tid = TIDX;
    LAS float* sc = (LAS float*)lds;
    LAS float* red = (LAS float*)(lds + 12288);
    float* mods = (float*)(a.ws + WS_MOD);
    for (int blk = blockIdx.x; blk < 256; blk += gridDim.x) {
        const int l = blk >> 7, n0 = (blk & 127) * 48;
        for (int i = tid; i < 3072; i += 512) { const int r = i >> 10, k = i & 1023; const float v = r == 0 ? a.c_ctx[k] : a.c[(r - 1) * 1024 + k]; sc[i] = silu_f(v); }
        __syncthreads();
        const int ks = tid / 12, c4 = tid - ks * 12;
        if (ks < 42) {
            const float* W = a.w_ada + (size_t)l * D * NMOD + n0 + 4 * c4;
            f32x4 a0 = (f32x4){0.f, 0.f, 0.f, 0.f}, a1 = a0, a2 = a0;
#pragma unroll 5
            for (int k = ks; k < 1024; k += 42) { const f32x4 wv = *(const f32x4*)(W + (size_t)k * NMOD); a0 += wv * sc[k]; a1 += wv * sc[1024 + k]; a2 += wv * sc[2048 + k]; }
            *(LAS f32x4*)(red + (ks * 3 + 0) * 48 + 4 * c4) = a0; *(LAS f32x4*)(red + (ks * 3 + 1) * 48 + 4 * c4) = a1; *(LAS f32x4*)(red + (ks * 3 + 2) * 48 + 4 * c4) = a2;
        }
        __syncthreads();
        if (tid < 144) { const int r = tid / 48, cc = tid - r * 48; float sm = 0.f;
            for (int w = 0; w < 42; ++w) sm += red[(w * 3 + r) * 48 + cc];
            mods[(l * 3 + r) * NMOD + n0 + cc] = sm + a.b_ada[l * NMOD + n0 + cc]; }
        __syncthreads();
    }
}
__device__ __forceinline__ void phase_norm(const Args& a, int l, const float* gain, int shift_off, bool first) {
    const int lane = TIDX & 63, wave = TIDX >> 6;
    const int gw = blockIdx.x * 8 + wave, NGW = gridDim.x * 8;
    const float* mods = (const float*)(a.ws + WS_MOD) + (size_t)l * 3 * NMOD;
    bf16* H = (bf16*)(a.ws + WS_H);
    f32x4 gn[4];
#pragma unroll
    for (int j = 0; j < 4; ++j) gn[j] = *(const f32x4*)(gain + 4 * (lane + 64 * j));
    for (int row = gw; row < M; row += NGW) {
        const int modrow = row < MP ? 0 : 1 + ((row - MP) >> 10);
        const float* src = first ? (row < MP ? a.x_prompt + (size_t)row * D : a.x_sample + (size_t)(row - MP) * D) : a.out + (size_t)row * D;
        f32x4 v[4]; float s = 0.f;
#pragma unroll
        for (int j = 0; j < 4; ++j) v[j] = *(const f32x4*)(src + 4 * (lane + 64 * j));
        if (first) {
            if (row >= MP) {
                const int n = (row - MP) & 1023; const float pr = (float)(n >> 6), pc = (float)(n & 63);
#pragma unroll
                for (int e = 0; e < 4; ++e) { const float om = expf(-(float)(4 * lane + e) * (9.210340371976184f / 256.f));
                    v[0][e] += sinf(pr * om); v[1][e] += cosf(pr * om); v[2][e] += sinf(pc * om); v[3][e] += cosf(pc * om); }
            }
#pragma unroll
            for (int j = 0; j < 4; ++j) *(f32x4*)(a.out + (size_t)row * D + 4 * (lane + 64 * j)) = v[j];
        }
#pragma unroll
        for (int j = 0; j < 4; ++j) s += (v[j][0] * v[j][0] + v[j][1] * v[j][1]) + (v[j][2] * v[j][2] + v[j][3] * v[j][3]);
        const float rstd = rsqrtf(wave_sum(s) * (1.f / D) + EPS);
        const float* mr = mods + modrow * NMOD + shift_off;
#pragma unroll
        for (int j = 0; j < 4; ++j) { const int c0 = 4 * (lane + 64 * j);
            const f32x4 sh = *(const f32x4*)(mr + c0), scl = *(const f32x4*)(mr + 1024 + c0);
            const f32x4 y = v[j] * rstd * gn[j] * (scl + 1.f) + sh;
            u32x2 o; o.x = pk2(y[0], y[1]); o.y = pk2(y[2], y[3]);
            *(u32x2*)(H + (size_t)row * D + c0) = o; }
    }
}
__device__ __forceinline__ void phase_final(const Args& a) {
    const int lane = TIDX & 63, wave = TIDX >> 6;
    const int gw = blockIdx.x * 8 + wave, NGW = gridDim.x * 8;
    f32x4 gn[4];
#pragma unroll
    for (int j = 0; j < 4; ++j) gn[j] = *(const f32x4*)(a.final_norm + 4 * (lane + 64 * j));
    for (int row = gw; row < M; row += NGW) {
        float* xr = a.out + (size_t)row * D;
        f32x4 v[4]; float s = 0.f;
#pragma unroll
        for (int j = 0; j < 4; ++j) { v[j] = *(const f32x4*)(xr + 4 * (lane + 64 * j)); s += (v[j][0] * v[j][0] + v[j][1] * v[j][1]) + (v[j][2] * v[j][2] + v[j][3] * v[j][3]); }
        const float rstd = rsqrtf(wave_sum(s) * (1.f / D) + EPS);
#pragma unroll
        for (int j = 0; j < 4; ++j) *(f32x4*)(xr + 4 * (lane + 64 * j)) = v[j] * rstd * gn[j];
    }
}

constexpr int SC_QT = 0, SC_KT = 4352, SC_QD = 8704, SC_KE = 13056, SC_VT = 18176, SC_AD = 23296, SC_BUF = 23808, SC_TOT = 2 * SC_BUF;
__device__ __forceinline__ s16x4 pack4(f32x4 v) { u32x2 p; p.x = pk2(v[0], v[1]); p.y = pk2(v[2], v[3]); return __builtin_bit_cast(s16x4, p); }
__device__ __forceinline__ void scan_item(const Args& a, LAS unsigned char* lds, int l, int s, int h, int d, int seg) {
    const int tid = TIDX, lane = tid & 63, w = tid >> 6, fr = lane & 15, fq = lane >> 4;
    const int k = (w & 1) * 64 + lane, tg = w >> 1;
    const int T = s < 32 ? 256 : 1024, base = s < 32 ? s * 256 : MP + (s - 32) * 1024, nch = 16, pos0 = 256 * seg;
    const bf16* Z = (const bf16*)(a.ws + WS_Z);
    bf16* OH = (bf16*)(a.ws + WS_H) + (size_t)d * M * 512;
    const int sidx = (((s - 32) * 4 + h) * 2 + d) * 4 + seg;
    bf16* QC = (bf16*)(a.ws + WS_QC) + (size_t)((((s - 32) * 4 + h) * 2 + d) * 1024) * 128;
    float run = 1.f;
    float lb = 0.f;
    if (l == 1) lb = sigm(a.lb_logits[(2 + d) * 512 + h * 128 + k] - a.lb_logits[d * 512 + h * 128 + k]);
    const float oml = 1.f - lb;
    f32x4 S[8];
    if (s >= 32 && seg == 0) { const float* st = a.state + ((((size_t)(s - 32) * 2 + l) * 2 + d) * 4 + h) * 16384;
#pragma unroll
        for (int r = 0; r < 8; ++r)
#pragma unroll
            for (int i = 0; i < 4; ++i) S[r][i] = st[(16 * r + 4 * fq + i) * 128 + 16 * w + fr];
    } else {
#pragma unroll
        for (int r = 0; r < 8; ++r) S[r] = (f32x4){0.f, 0.f, 0.f, 0.f};
    }
    LAS float* TOT = (LAS float*)(lds + SC_TOT);
    const int zcol_q = ZQ + h * 128 + k, zcol_f = ZFF + d * 512 + h * 128 + k, zcol_i = ZI + h * 128 + k;
    unsigned short nq[4], nf[4], ni[4];
#define SC_TOK(c, j) (d == 0 ? pos0 + 16 * (c) + (j) : T - 1 - pos0 - 16 * (c) - (j))
#define SC_ROW(c, j) (base + SC_TOK(c, j))
#define SC_BAR() do { asm volatile("s_waitcnt lgkmcnt(0)" ::: "memory"); __builtin_amdgcn_s_barrier(); asm volatile("" ::: "memory"); } while (0)
#pragma unroll
    for (int e = 0; e < 4; ++e) { const size_t ro = (size_t)SC_ROW(0, 4 * tg + e) * NZ; nq[e] = Z[ro + zcol_q]; nf[e] = Z[ro + zcol_f]; ni[e] = Z[ro + zcol_i]; }
    {
      for (int c = 0; c < nch; ++c) {
        float q[4], kk[4], pf[4], vv[4];
#pragma unroll
        for (int e = 0; e < 4; ++e) {
            const float zf = fmaxf(bf2f(nf[e]), -30.f), ex = __expf(-zf), sg = frcp(1.f + ex);
            pf[e] = lb + oml * sg; kk[e] = oml * ex * sg; q[e] = bf2f(nq[e]); vv[e] = bf2f(ni[e]);
        }
        if (c + 1 < nch) {
#pragma unroll
            for (int e = 0; e < 4; ++e) { const size_t ro = (size_t)SC_ROW(c + 1, 4 * tg + e) * NZ; nq[e] = Z[ro + zcol_q]; nf[e] = Z[ro + zcol_f]; ni[e] = Z[ro + zcol_i]; }
        }
        pf[1] *= pf[0]; pf[2] *= pf[1]; pf[3] *= pf[2];
        TOT[tg * 128 + k] = pf[3];
        SC_BAR();
        const float t0 = TOT[k], t1 = TOT[128 + k], t2 = TOT[256 + k], t3 = TOT[384 + k];
        const float off = (tg > 0 ? t0 : 1.f) * (tg > 1 ? t1 : 1.f) * (tg > 2 ? t2 : 1.f), pref = t0 * t1, p15 = pref * (t2 * t3);
        const float ipref = frcp(fmaxf(pref, 1e-30f));
        LAS unsigned char* B = lds + (c & 1) * SC_BUF;
        float ke[4];
#pragma unroll
        for (int e = 0; e < 4; ++e) { const float P = off * pf[e], iP = frcp(fmaxf(P, 1e-30f)); const int j = 4 * tg + e;
            const unsigned w0 = pk2(q[e] * (P * ipref), kk[e] * (pref * iP)), w1 = pk2(q[e] * P, 0.f);
            ((LAS bf16*)(B + SC_QT))[j * 136 + k] = (bf16)(w0 & 0xffffu);
            ((LAS bf16*)(B + SC_KT))[j * 136 + k] = (bf16)(w0 >> 16);
            ((LAS bf16*)(B + SC_QD))[j * 136 + k] = (bf16)(w1 & 0xffffu);
            if (s >= 32) QC[(size_t)SC_TOK(c, j) * 128 + k] = (bf16)(pk2(q[e] * P * run, 0.f) & 0xffffu);
            ke[e] = kk[e] * (p15 * iP); }
        run *= p15;
        { u32x2 p; p.x = pk2(ke[0], ke[1]); p.y = pk2(ke[2], ke[3]); *(LAS u32x2*)(B + SC_KE + k * 40 + tg * 8) = p;
          p.x = pk2(vv[0], vv[1]); p.y = pk2(vv[2], vv[3]); *(LAS u32x2*)(B + SC_VT + k * 40 + tg * 8) = p; }
        if (tg == 0) ((LAS float*)(B + SC_AD))[k] = p15;
        SC_BAR();
        f32x4 pt = (f32x4){0.f, 0.f, 0.f, 0.f};
#pragma unroll
        for (int k4 = 0; k4 < 4; ++k4) {
            const bf16x8 ka = *(const LAS bf16x8*)(B + SC_KT + fr * 272 + k4 * 64 + fq * 16);
            const bf16x8 qb = *(const LAS bf16x8*)(B + SC_QT + fr * 272 + k4 * 64 + fq * 16);
            pt = __builtin_amdgcn_mfma_f32_16x16x32_bf16(ka, qb, pt, 0, 0, 0);
        }
#pragma unroll
        for (int i = 0; i < 4; ++i) if (4 * fq + i > fr) pt[i] = 0.f;
        const s16x4 pa = pack4(pt);
        const s16x4 vb = *(const LAS s16x4*)(B + SC_VT + (16 * w + fr) * 40 + fq * 8);
        f32x4 o = __builtin_amdgcn_mfma_f32_16x16x16bf16_1k(pa, vb, (f32x4){0.f, 0.f, 0.f, 0.f}, 0, 0, 0);
#pragma unroll
        for (int r = 0; r < 8; ++r) {
            const s16x4 qa = *(const LAS s16x4*)(B + SC_QD + fr * 272 + r * 32 + fq * 8);
            o = __builtin_amdgcn_mfma_f32_16x16x16bf16_1k(qa, pack4(S[r]), o, 0, 0, 0);
        }
#pragma unroll
        for (int r = 0; r < 8; ++r) {
            const f32x4 ad = *(const LAS f32x4*)(B + SC_AD + (16 * r + 4 * fq) * 4);
            const s16x4 ka = *(const LAS s16x4*)(B + SC_KE + (16 * r + fr) * 40 + fq * 8);
            S[r] = __builtin_amdgcn_mfma_f32_16x16x16bf16_1k(ka, vb, S[r] * ad, 0, 0, 0);
        }
#pragma unroll
        for (int i = 0; i < 4; ++i) OH[(size_t)SC_ROW(c, 4 * fq + i) * 512 + h * 128 + 16 * w + fr] = (bf16)(pk2(o[i], 0.f) & 0xffffu);
      }
    }
#undef SC_ROW
#undef SC_TOK
#undef SC_BAR
    if (s >= 32) { float* sl = (float*)(a.ws + WS_SL) + (size_t)sidx * 16384;
#pragma unroll
        for (int r = 0; r < 8; ++r)
#pragma unroll
            for (int i = 0; i < 4; ++i) sl[(16 * r + 4 * fq + i) * 128 + 16 * w + fr] = S[r][i];
        if (tg == 0) ((float*)(a.ws + WS_AS))[sidx * 128 + k] = run; }
    if (s < 32) { float* st = a.out + (size_t)M * D + ((((size_t)s * 2 + l) * 2 + d) * 4 + h) * 16384;
#pragma unroll
        for (int r = 0; r < 8; ++r)
#pragma unroll
            for (int i = 0; i < 4; ++i) st[(16 * r + 4 * fq + i) * 128 + 16 * w + fr] = S[r][i]; }
    __syncthreads();
}
__device__ __forceinline__ void mm128(const LAS bf16* As, const LAS bf16* Bs, f32x4 (&acc)[2][4], int wr, int wc, int fr, int fq, bool zero = true) {
    if (zero) {
#pragma unroll
    for (int mt = 0; mt < 2; ++mt)
#pragma unroll
        for (int nt = 0; nt < 4; ++nt) acc[mt][nt] = (f32x4){0.f, 0.f, 0.f, 0.f}; }
#pragma unroll
    for (int k4 = 0; k4 < 4; ++k4) {
        bf16x8 af[2];
#pragma unroll
        for (int mt = 0; mt < 2; ++mt) af[mt] = *(const LAS bf16x8*)(As + (32 * wr + 16 * mt + fr) * 136 + 32 * k4 + 8 * fq);
#pragma unroll
        for (int nt = 0; nt < 4; ++nt) {
            const bf16x8 bfr = *(const LAS bf16x8*)(Bs + (64 * wc + 16 * nt + fr) * 136 + 32 * k4 + 8 * fq);
#pragma unroll
            for (int mt = 0; mt < 2; ++mt) acc[mt][nt] = __builtin_amdgcn_mfma_f32_16x16x32_bf16(af[mt], bfr, acc[mt][nt], 0, 0, 0);
        }
    }
}
__device__ __forceinline__ void stage_f32_tile(const float* W, LAS bf16* T) {
#pragma unroll
    for (int it = 0; it < 8; ++it) { const int idx = TIDX * 4 + 2048 * it, r = idx >> 7, cc = idx & 127;
        const f32x4 v = *(const f32x4*)(W + idx); u32x2 o; o.x = pk2(v[0], v[1]); o.y = pk2(v[2], v[3]); *(LAS u32x2*)(T + r * 136 + cc) = o; }
}
__device__ __forceinline__ void stage_f32_tile_T(const float* W, LAS bf16* T) {
#pragma unroll
    for (int it = 0; it < 4; ++it) { const int p = TIDX + 512 * it, n = p & 127, k0 = (p >> 7) * 8;
        float v[8];
#pragma unroll
        for (int e = 0; e < 8; ++e) v[e] = W[(size_t)(k0 + e) * 128 + n];
        u32x4 o; o.x = pk2(v[0], v[1]); o.y = pk2(v[2], v[3]); o.z = pk2(v[4], v[5]); o.w = pk2(v[6], v[7]);
        *(LAS u32x4*)(T + n * 136 + k0) = o; }
}
__device__ __forceinline__ void sg_item(const Args& a, LAS unsigned char* lds, int l, int ci) {
    const int tid = TIDX, lane = tid & 63, w = tid >> 6, fr = lane & 15, fq = lane >> 4, wr = w >> 1, wc = w & 1;
    const int r0 = ci * 128;
    const bf16* Z = (const bf16*)(a.ws + WS_Z);
    bf16* O = (bf16*)(a.ws + WS_O3) + (size_t)M * 512;
    LAS bf16* As = (LAS bf16*)lds; LAS bf16* Bs = (LAS bf16*)(lds + 34816); LAS float* rstd = (LAS float*)(lds + 69632);
    { u32x4 zz[16];
#pragma unroll
      for (int rr = 0; rr < 16; ++rr) zz[rr] = *(const u32x4*)(Z + (size_t)(r0 + 16 * w + rr) * NZ + ZV + 8 * lane);
#pragma unroll
      for (int rr = 0; rr < 16; ++rr) { float ss = 0.f;
#pragma unroll
        for (int e = 0; e < 4; ++e) { const float g0 = bflo(zz[rr][e]), g1 = bfhi(zz[rr][e]); ss += g0 * g0 + g1 * g1; }
        ss = wave_sum(ss); if (lane == 0) rstd[16 * w + rr] = rsqrtf(ss * (1.f / 512.f) + EPS); } }
    __syncthreads();
    for (int g = 0; g < 4; ++g) {
        stage_f32_tile(a.sg_w + ((size_t)l * 4 + g) * 16384, As);
#pragma unroll
        for (int it = 0; it < 4; ++it) { const int p = tid + 512 * it, c = p & 127, s0 = (p >> 7) * 8;
            const float gn = a.sg_norm[l * 512 + g * 128 + c];
            float v[8];
#pragma unroll
            for (int e = 0; e < 8; ++e) v[e] = bf2f(Z[(size_t)(r0 + s0 + e) * NZ + ZV + g * 128 + c]) * rstd[s0 + e] * gn;
            u32x4 o; o.x = pk2(v[0], v[1]); o.y = pk2(v[2], v[3]); o.z = pk2(v[4], v[5]); o.w = pk2(v[6], v[7]);
            *(LAS u32x4*)(Bs + c * 136 + s0) = o; }
        __syncthreads();
        f32x4 acc[2][4]; mm128(As, Bs, acc, wr, wc, fr, fq);
        { unsigned short uu[2][4][4]; float bias[2][4];
#pragma unroll
          for (int mt = 0; mt < 2; ++mt)
#pragma unroll
            for (int i = 0; i < 4; ++i) { const int row = 32 * wr + 16 * mt + 4 * fq + i; bias[mt][i] = a.sg_b[(l * 4 + g) * 128 + row];
#pragma unroll
                for (int nt = 0; nt < 4; ++nt) uu[mt][i][nt] = Z[(size_t)(r0 + row) * NZ + ZU + g * 128 + 64 * wc + 16 * nt + fr]; }
#pragma unroll
          for (int mt = 0; mt < 2; ++mt)
#pragma unroll
            for (int i = 0; i < 4; ++i) { const int row = 32 * wr + 16 * mt + 4 * fq + i;
#pragma unroll
                for (int nt = 0; nt < 4; ++nt) { const int col = g * 128 + 64 * wc + 16 * nt + fr;
                    O[(size_t)(r0 + row) * 512 + col] = (bf16)(pk2(bf2f(uu[mt][i][nt]) * (acc[mt][nt][i] + bias[mt][i]), 0.f) & 0xffffu); } } }
        __syncthreads();
    }
}
__device__ __forceinline__ void pool_item(const Args& a, LAS unsigned char* lds, int l, int ci) {
    const int tid = TIDX, lane = tid & 63, w = tid >> 6, fr = lane & 15, fq = lane >> 4, wr = w >> 1, wc = w & 1;
    const int r0 = ci * 128;
    const int T = r0 < MP ? 256 : 1024, base = r0 < MP ? (r0 & ~255) : MP + ((r0 - MP) & ~1023), t0 = r0 - base;
    const bf16* Z = (const bf16*)(a.ws + WS_Z);
    bf16* O = (bf16*)(a.ws + WS_O3) + (size_t)2 * M * 512;
    LAS bf16* As = (LAS bf16*)lds; LAS bf16* Bs = (LAS bf16*)(lds + 34816); LAS bf16* Ts = (LAS bf16*)(lds + 69632);
    const int c = tid & 127, seg = tid >> 7;
    for (int g = 0; g < 4; ++g) {
        const int hw = 1 << g;
        stage_f32_tile_T(a.pool_w + ((size_t)l * 4 + g) * 16384, Bs);
#pragma unroll
        for (int it = 0; it < 5; ++it) { const int ch = tid + 512 * it;
            if (ch < 2304) { const int rr = ch >> 4, c8 = (ch & 15) * 8, tau = t0 - 8 + rr;
                u32x4 v = (u32x4){0u, 0u, 0u, 0u};
                if (tau >= 0 && tau < T) v = *(const u32x4*)(Z + (size_t)(base + tau) * NZ + ZP + g * 128 + c8);
                *(LAS u32x4*)(Ts + rr * 136 + c8) = v; } }
        __syncthreads();
        {
            const int ts = t0 + 32 * seg;
            const LAS bf16* tp = Ts + (32 * seg + 8) * 136 + c;
            float sum = 0.f;
            for (int dd = -hw; dd < hw; ++dd) sum += bf2f(tp[dd * 136]);
#pragma unroll 8
            for (int tt = 0; tt < 32; ++tt) { const int t = ts + tt;
                const int lo = t - hw < 0 ? 0 : t - hw, hi = t + hw > T ? T : t + hw;
                const float cur = bf2f(tp[tt * 136]);
                As[(32 * seg + tt) * 136 + c] = (bf16)(pk2(sum * frcp((float)(hi - lo)) - cur, 0.f) & 0xffffu);
                sum += bf2f(tp[(tt + hw) * 136]) - bf2f(tp[(tt - hw) * 136]); }
        }
        __syncthreads();
        f32x4 acc[2][4]; mm128(As, Bs, acc, wr, wc, fr, fq);
#pragma unroll
        for (int nt = 0; nt < 4; ++nt) { const int col = g * 128 + 64 * wc + 16 * nt + fr; const float sc = a.pool_scale[l * 512 + col];
#pragma unroll
            for (int mt = 0; mt < 2; ++mt)
#pragma unroll
                for (int i = 0; i < 4; ++i) { const int row = 32 * wr + 16 * mt + 4 * fq + i; O[(size_t)(r0 + row) * 512 + col] = (bf16)(pk2(acc[mt][nt][i] * sc, 0.f) & 0xffffu); } }
        __syncthreads();
    }
}
__device__ __forceinline__ void phase_mixers(const Args& a, LAS unsigned char* lds, int l) {
    for (int it = blockIdx.x; it < 480; it += (int)gridDim.x) {
        if (it < 256) { for (int rp = 0; rp <= ((REPMASK >> 10) & 1); ++rp) scan_item(a, lds, l, it >> 3, (it >> 1) & 3, it & 1, 0); }
        else if (it < 320) { const int p = it - 256; for (int rp = 0; rp <= ((REPMASK >> 10) & 1); ++rp) scan_item(a, lds, l, 32 + (p >> 5), (p >> 3) & 3, (p >> 2) & 1, p & 3); }
        else if (it < 400) { for (int rp = 0; rp <= ((REPMASK >> 11) & 1); ++rp) sg_item(a, lds, l, it - 320); }
        else { for (int rp = 0; rp <= ((REPMASK >> 12) & 1); ++rp) pool_item(a, lds, l, it - 400); }
    }
    for (int rp = 0; rp < ((REPMASK >> 13) & 1); ++rp) convert_set(a, lds, l, l == 0 ? 0x7e : 0x40, (int)blockIdx.x * 8 + (TIDX >> 6), (int)gridDim.x * 8);
    if (l == 0) convert_set(a, lds, 0, 0x1e, (int)blockIdx.x * 8 + (TIDX >> 6), (int)gridDim.x * 8);
}
__device__ __forceinline__ void phase_combine(const Args& a, int l, int bidx, int nblk) {
    const int lane = TIDX & 63, wave = TIDX >> 6;
    const int gw = bidx * 8 + wave, NGW = nblk * 8;
    const bf16* Z = (const bf16*)(a.ws + WS_Z); const bf16* OF = (const bf16*)(a.ws + WS_H); const bf16* OB = OF + (size_t)M * 512;
    bf16* O = (bf16*)(a.ws + WS_O3);
    const int c8 = 8 * lane;
    const f32x4 g0 = *(const f32x4*)(a.hg_norm + l * 128 + (c8 & 127)), g1 = *(const f32x4*)(a.hg_norm + l * 128 + (c8 & 127) + 4);
    for (int row = gw; row < MP; row += NGW) {
        const u32x4 f = *(const u32x4*)(OF + (size_t)row * 512 + c8), bb = *(const u32x4*)(OB + (size_t)row * 512 + c8), zg = *(const u32x4*)(Z + (size_t)row * NZ + ZG + c8);
        float v[8], ss = 0.f;
#pragma unroll
        for (int e = 0; e < 4; ++e) { v[2 * e] = bflo(f[e]) + bflo(bb[e]); v[2 * e + 1] = bfhi(f[e]) + bfhi(bb[e]); ss += v[2 * e] * v[2 * e] + v[2 * e + 1] * v[2 * e + 1]; }
        ss += __shfl_xor(ss, 1); ss += __shfl_xor(ss, 2); ss += __shfl_xor(ss, 4); ss += __shfl_xor(ss, 8);
        const float r = rsqrtf(ss * (1.f / 128.f) + EPS);
        u32x4 o;
        o.x = pk2(v[0] * r * g0[0] * bflo(zg.x), v[1] * r * g0[1] * bfhi(zg.x));
        o.y = pk2(v[2] * r * g0[2] * bflo(zg.y), v[3] * r * g0[3] * bfhi(zg.y));
        o.z = pk2(v[4] * r * g1[0] * bflo(zg.z), v[5] * r * g1[1] * bfhi(zg.z));
        o.w = pk2(v[6] * r * g1[2] * bflo(zg.w), v[7] * r * g1[3] * bfhi(zg.w));
        *(u32x4*)(O + (size_t)row * 512 + c8) = o;
    }
}
__device__ __forceinline__ void sample_combine_item(const Args& a, LAS unsigned char* lds, int l, int sq, int tseg, int h, int hf0) {
    const int tid = TIDX, lane = tid & 63, w = tid >> 6, fr = lane & 15, fq = lane >> 4, wr = w >> 1, wc = w & 1;
    LAS bf16* As = (LAS bf16*)lds; LAS bf16* Bs = (LAS bf16*)(lds + 34816); LAS float* Ct = (LAS float*)lds;
    const bf16* Z = (const bf16*)(a.ws + WS_Z); const bf16* OF = (const bf16*)(a.ws + WS_H); const bf16* OB = OF + (size_t)M * 512;
    bf16* O = (bf16*)(a.ws + WS_O3);
    const float* SL = (const float*)(a.ws + WS_SL); const float* AS = (const float*)(a.ws + WS_AS);
    const int hf = hf0;
    f32x4 acc[2][4];
#pragma unroll
    for (int mt = 0; mt < 2; ++mt)
#pragma unroll
        for (int nt = 0; nt < 4; ++nt) acc[mt][nt] = (f32x4){0.f, 0.f, 0.f, 0.f};
    for (int d = 0; d < 2; ++d) {
        const int g = d == 0 ? tseg : 3 - tseg;
        if (g == 0) continue;
        const int ib = ((sq * 4 + h) * 2 + d) * 4;
#pragma unroll
        for (int it = 0; it < 4; ++it) { const int p = tid + 512 * it, v = p & 127, k0 = (p >> 7) * 8;
            float E[8];
#pragma unroll
            for (int e = 0; e < 8; ++e) E[e] = SL[(size_t)ib * 16384 + (k0 + e) * 128 + v];
            for (int gg = 1; gg < g; ++gg) {
#pragma unroll
                for (int e = 0; e < 8; ++e) E[e] = E[e] * AS[(ib + gg) * 128 + k0 + e] + SL[(size_t)(ib + gg) * 16384 + (k0 + e) * 128 + v]; }
            u32x4 o; o.x = pk2(E[0], E[1]); o.y = pk2(E[2], E[3]); o.z = pk2(E[4], E[5]); o.w = pk2(E[6], E[7]);
            *(LAS u32x4*)(Bs + v * 136 + k0) = o; }
        const bf16* QC = (const bf16*)(a.ws + WS_QC) + (size_t)(((sq * 4 + h) * 2 + d) * 1024 + 256 * tseg) * 128;
        {
#pragma unroll
            for (int it = 0; it < 4; ++it) { const int ch = tid + 512 * it, r = ch >> 4, c8 = (ch & 15) * 8;
                *(LAS u32x4*)(As + r * 136 + c8) = *(const u32x4*)(QC + (size_t)(128 * hf + r) * 128 + c8); }
            __syncthreads();
            mm128(As, Bs, acc, wr, wc, fr, fq, false);
            __syncthreads();
        }
    }
    const float gn0 = a.hg_norm[l * 128 + 2 * lane], gn1 = a.hg_norm[l * 128 + 2 * lane + 1];
    {
#pragma unroll
        for (int mt = 0; mt < 2; ++mt)
#pragma unroll
            for (int nt = 0; nt < 4; ++nt)
#pragma unroll
                for (int i = 0; i < 4; ++i) Ct[(32 * wr + 16 * mt + 4 * fq + i) * 132 + 64 * wc + 16 * nt + fr] = acc[mt][nt][i];
        __syncthreads();
        { unsigned pf_[16], pb_[16], zg[16];
          const int grow0 = MP + sq * 1024 + 256 * tseg + 128 * hf + 16 * w;
#pragma unroll
          for (int rr = 0; rr < 16; ++rr) { const size_t go = (size_t)(grow0 + rr) * 512 + h * 128 + 2 * lane;
              pf_[rr] = *(const unsigned*)(OF + go); pb_[rr] = *(const unsigned*)(OB + go); zg[rr] = *(const unsigned*)(Z + (size_t)(grow0 + rr) * NZ + ZG + h * 128 + 2 * lane); }
#pragma unroll
          for (int rr = 0; rr < 16; ++rr) { const int r = 16 * w + rr; const size_t go = (size_t)(grow0 + rr) * 512 + h * 128 + 2 * lane;
              const float v0 = Ct[r * 132 + 2 * lane] + bflo(pf_[rr]) + bflo(pb_[rr]), v1 = Ct[r * 132 + 2 * lane + 1] + bfhi(pf_[rr]) + bfhi(pb_[rr]);
              const float rs = rsqrtf(wave_sum(v0 * v0 + v1 * v1) * (1.f / 128.f) + EPS);
              *(unsigned*)(O + go) = pk2(v0 * rs * gn0 * bflo(zg[rr]), v1 * rs * gn1 * bfhi(zg[rr])); } }
        __syncthreads();
    }
}
__device__ __forceinline__ void phase_conv(const Args& a, int l) {
    const bf16* HF = (const bf16*)(a.ws + WS_Z); bf16* ACT = (bf16*)(a.ws + WS_O3);
    const float* cw = a.conv_w + (size_t)l * 3 * NUP; const float* cb = a.conv_b + (size_t)l * NUP;
    const int total = (M / 8) * 352;
    for (int idx = blockIdx.x * 512 + TIDX; idx < total; idx += (int)gridDim.x * 512) {
        const int run = idx / 352, j0 = (idx - run * 352) * 8, row0 = run * 8;
        const int t0 = row0 < MP ? (row0 & 255) : ((row0 - MP) & 1023), T = row0 < MP ? 256 : 1024;
        float r[2][8][8];
#pragma unroll
        for (int hf = 0; hf < 2; ++hf) { const int col = hf * DFF + j0; const bf16* hp0 = HF + (size_t)row0 * NUP + col;
            u32x4 h[10];
#pragma unroll
            for (int q = 0; q < 10; ++q) { const int t = t0 - 1 + q; h[q] = (t >= 0 && t < T) ? *(const u32x4*)(hp0 + (ptrdiff_t)(q - 1) * NUP) : (u32x4){0u, 0u, 0u, 0u}; }
            const f32x4 wa0 = *(const f32x4*)(cw + col), wa1 = *(const f32x4*)(cw + col + 4), wb0 = *(const f32x4*)(cw + NUP + col), wb1 = *(const f32x4*)(cw + NUP + col + 4);
            const f32x4 wc0 = *(const f32x4*)(cw + 2 * NUP + col), wc1 = *(const f32x4*)(cw + 2 * NUP + col + 4), bi0 = *(const f32x4*)(cb + col), bi1 = *(const f32x4*)(cb + col + 4);
#pragma unroll
            for (int e = 0; e < 4; ++e) {
                const float w0l = e < 2 ? wa0[2 * e] : wa1[2 * e - 4], w0h = e < 2 ? wa0[2 * e + 1] : wa1[2 * e - 3];
                const float w1l = e < 2 ? wb0[2 * e] : wb1[2 * e - 4], w1h = e < 2 ? wb0[2 * e + 1] : wb1[2 * e - 3];
                const float w2l = e < 2 ? wc0[2 * e] : wc1[2 * e - 4], w2h = e < 2 ? wc0[2 * e + 1] : wc1[2 * e - 3];
                const float bl = e < 2 ? bi0[2 * e] : bi1[2 * e - 4], bh = e < 2 ? bi0[2 * e + 1] : bi1[2 * e - 3];
#pragma unroll
                for (int q = 0; q < 8; ++q) {
                    r[hf][q][2 * e] = w0l * bflo(h[q][e]) + w1l * bflo(h[q + 1][e]) + w2l * bflo(h[q + 2][e]) + bl;
                    r[hf][q][2 * e + 1] = w0h * bfhi(h[q][e]) + w1h * bfhi(h[q + 1][e]) + w2h * bfhi(h[q + 2][e]) + bh; } } }
#pragma unroll
        for (int q = 0; q < 8; ++q) { u32x4 o;
            o.x = pk2(silu_f(r[0][q][0]) * r[1][q][0], silu_f(r[0][q][1]) * r[1][q][1]); o.y = pk2(silu_f(r[0][q][2]) * r[1][q][2], silu_f(r[0][q][3]) * r[1][q][3]);
            o.z = pk2(silu_f(r[0][q][4]) * r[1][q][4], silu_f(r[0][q][5]) * r[1][q][5]); o.w = pk2(silu_f(r[0][q][6]) * r[1][q][6], silu_f(r[0][q][7]) * r[1][q][7]);
            *(u32x4*)(ACT + (size_t)(row0 + q) * DFF + j0) = o; }
    }
}

#define XB_TMO      128
#define XB_XCNT(j)  (256  + 64 * (j))
#define XB_XSUB(j)  (1280 + 64 * (j))
#define XB_XGEN(j)  (2304 + 64 * (j))
#define XB_TOP      3328
#define XB_TOPGEN   3392
#define XCD_BAR_WORDS 3456
#define XB_SPIN_CAP (1u << 18)

__device__ __forceinline__ unsigned xb_ld(unsigned* p)              { return __hip_atomic_load(p, __ATOMIC_RELAXED, __HIP_MEMORY_SCOPE_AGENT); }
__device__ __forceinline__ unsigned xb_add(unsigned* p, unsigned v) { return __hip_atomic_fetch_add(p, v, __ATOMIC_RELAXED, __HIP_MEMORY_SCOPE_AGENT); }
__device__ __forceinline__ unsigned xb_xcc_id() { return (unsigned)__builtin_amdgcn_s_getreg((3 << 11) | 20) & 0xFu; }
#define XB_SPIN(cond, bar) do { unsigned _sp = 0; while (cond) { __builtin_amdgcn_s_sleep(1); \
    if ((++_sp & 255u) == 0u) { if (xb_ld(&(bar)[XB_TMO])) break; if (_sp > XB_SPIN_CAP) { atomicAdd(&(bar)[XB_TMO], 1u); break; } } } } while (0)

struct XcdBarrier {
    unsigned* bar; unsigned x;
    volatile LAS unsigned* st;
};

__device__ __forceinline__ XcdBarrier xcd_barrier_post(unsigned* bar, volatile LAS unsigned* st) {
    XcdBarrier b; b.bar = bar; b.x = xb_xcc_id(); b.st = st;
    if (threadIdx.x == 0) (void)xb_add(&bar[XB_XCNT(b.x)], 1u);
    return b;
}
__device__ __forceinline__ void xcd_barrier_complete(unsigned* bar, unsigned x, unsigned& nloc, unsigned& nx) {
    const unsigned G = gridDim.x * gridDim.y * gridDim.z;
    unsigned sum, cnt, mine, sp = 0u;
    for (;;) {
        sum = 0u; cnt = 0u; mine = 0u;
#pragma unroll
        for (unsigned j = 0; j < 16; ++j) { const unsigned c = xb_ld(&bar[XB_XCNT(j)]); sum += c; cnt += (c > 0u) ? 1u : 0u; mine = (j == x) ? c : mine; }
        if (sum == G) break;
        __builtin_amdgcn_s_sleep(1);
        if ((++sp & 255u) == 0u) { if (xb_ld(&bar[XB_TMO])) break; if (sp > XB_SPIN_CAP) { atomicAdd(&bar[XB_TMO], 1u); break; } }
    }
    nloc = mine > 0u ? mine : 1u; nx = cnt > 0u ? cnt : 1u;
}

__device__ __forceinline__ void xcd_barrier(const XcdBarrier& b) {
    asm volatile("s_waitcnt vmcnt(0)" ::: "memory");
    __syncthreads();
    if (threadIdx.x == 0) {
        unsigned* bar = b.bar;
        __builtin_amdgcn_s_waitcnt(0);
        unsigned nloc = b.st[0], nx = b.st[1];
        if (nloc == 0u) { xcd_barrier_complete(bar, b.x, nloc, nx); b.st[0] = nloc; b.st[1] = nx; }
        const unsigned old = xb_add(&bar[XB_XSUB(b.x)], 1u);
        const unsigned gen = old / nloc;
        if (old + 1u == (gen + 1u) * nloc) {
            __builtin_amdgcn_fence(__ATOMIC_RELEASE, "agent");
            asm volatile("s_waitcnt vmcnt(0)" ::: "memory");
            const unsigned og = xb_add(&bar[XB_TOP], 1u);
            const unsigned tg = og / nx;
            if (og + 1u == (tg + 1u) * nx) xb_add(&bar[XB_TOPGEN], 1u);
            else XB_SPIN(xb_ld(&bar[XB_TOPGEN]) == tg, bar);
            __builtin_amdgcn_fence(__ATOMIC_ACQUIRE, "agent");
            xb_add(&bar[XB_XGEN(b.x)], 1u);
            asm volatile("s_waitcnt vmcnt(0)" ::: "memory");
        } else {
            XB_SPIN(xb_ld(&bar[XB_XGEN(b.x)]) == gen, bar);
            __builtin_amdgcn_fence(__ATOMIC_ACQUIRE, "agent");
            asm volatile("s_waitcnt vmcnt(0)" ::: "memory");
        }
    }
    __syncthreads();
}

__global__ void __launch_bounds__(512, 2) fwd_kernel(Args a) {
    extern __shared__ __attribute__((aligned(16))) unsigned char lds_raw[];
    LAS unsigned char* lds = (LAS unsigned char*)lds_raw;
    cg::grid_group grid = cg::this_grid();
    unsigned char* ws = a.ws;
    const int G = gridDim.x, bid = blockIdx.x;
    if (threadIdx.x < 4) ((volatile LAS unsigned*)(lds + 131072 + 64))[threadIdx.x] = 0u;
    __syncthreads();
    const XcdBarrier bar = xcd_barrier_post((unsigned*)(a.ws + WS_BAR), (volatile LAS unsigned*)(lds + 131072 + 64));
    for (int ph = a.ph_lo; ph < a.ph_hi; ++ph) {
        if (ph == 0 && PHSEL(100)) { phase_mods(a, lds); convert_set(a, lds, 0, 1, bid * 8 + (TIDX >> 6), G * 8); }
        else if (ph == NPHASE - 1 && PHSEL(101)) { phase_final(a); }
        else {
            const int l = (ph - 1) / 10, sp = (ph - 1) % 10;
            for (int rep = 0; rep <= ((REPMASK >> sp) & 1); ++rep) {
            const float* mods = (const float*)(ws + WS_MOD) + (size_t)l * 3 * NMOD;
            if ((sp == 0 || sp == 6) && PHSEL(0)) { phase_norm(a, l, (sp == 0 ? a.norm_mix : a.norm_ffn) + l * D, sp == 0 ? 0 : 3 * D, sp == 0 && l == 0); }
            else if ((sp == 1 || sp == 7) && PHSEL(1)) {
                const bool up = sp == 7;
                pg8::Gemm g{(const bf16*)(ws + WS_H), (const bf16*)(ws + (up ? WS_WUP : WS_WIN)), M, up ? NUP : NZ, D}; pg8::StaticOrder S; S.init(M, up ? NUP : NZ, G, bid);
                pg8::EpiZ E{(bf16*)(ws + WS_Z), up ? NUP : NZ, up ? 1 : 0}; if (up) pg8::gemm_phase<pg8::EpiZ, pg8::StaticOrder, false, true>(lds, g, S, E);
                else pg8::gemm_phase<pg8::EpiZ, pg8::StaticOrder, true, true>(lds, g, S, E); }
            else if (sp == 2 && PHSEL(2)) { phase_mixers(a, lds, l); }
            else if (sp == 3 && PHSEL(3)) { if (bid < 64) sample_combine_item(a, lds, l, bid >> 5, (bid >> 3) & 3, (bid >> 1) & 3, bid & 1); else phase_combine(a, l, bid - 64, G - 64); }
            else if (sp == 4 && PHSEL(4)) { pg8::Gemm g{(const bf16*)(ws + WS_O3), (const bf16*)(ws + WS_WBR), M, D, 512}; pg8::TileOrder S{bid, 3};
                pg8::EpiBranch E{(const bf16*)(ws + WS_Z), (bf16*)(ws + WS_H)}; pg8::gemm_phase<pg8::EpiBranch, pg8::TileOrder, true, true>(lds, g, S, E);
                if ((bid >> 3) >= 20) convert_set(a, lds, l, l == 0 ? 0x60 : 0x40, ((bid >> 3) - 20) * 64 + (bid & 7) * 8 + (TIDX >> 6), 12 * 64); }
            else if ((sp == 5 || sp == 9) && PHSEL(5)) {
                const bool dn = sp == 9;
                pg8::Gemm g{(const bf16*)(ws + (dn ? WS_O3 : WS_H)), (const bf16*)(ws + (dn ? WS_WDN : WS_WOUT)), M, D, dn ? DFF : D}; pg8::TileOrder S{bid, 1};
                pg8::EpiResid E{a.out, mods + (dn ? 5 * D : 2 * D)}; pg8::gemm_phase<pg8::EpiResid, pg8::TileOrder, true, true>(lds, g, S, E);
                if (dn && l == 0 && (bid >> 3) >= 20) convert_set(a, lds, 1, 0x3f, ((bid >> 3) - 20) * 64 + (bid & 7) * 8 + (TIDX >> 6), 12 * 64); }
            else if (sp == 8 && PHSEL(8)) { phase_conv(a, l); }
            }
        }
        if (ph + 1 < a.ph_hi) { if (a.ph_hi > 1000) grid.sync(); else xcd_barrier(bar); }
    }
}

extern "C" void kernel_launch(void* const* d_in, const int* in_sizes, int n_in, void* d_out, int out_size, void* d_ws, size_t ws_size, hipStream_t stream) {
    static int grid = 0;
    if (grid == 0) {
        if (n_in != 26 || ws_size < WS_END) { fprintf(stderr, "kernel_launch: expected 26 inputs and >= %zu bytes of workspace (got %d, %zu)\n", (size_t)WS_END, n_in, ws_size); grid = -1; return; }
        int dev = 0, cus = 0, per_cu = 0;
        hipGetDevice(&dev); hipDeviceGetAttribute(&cus, hipDeviceAttributeMultiprocessorCount, dev);
        if (hipFuncSetAttribute((const void*)fwd_kernel, hipFuncAttributeMaxDynamicSharedMemorySize, LDS_BYTES) != hipSuccess) { fprintf(stderr, "kernel_launch: hipFuncSetAttribute failed\n"); grid = -1; return; }
        hipOccupancyMaxActiveBlocksPerMultiprocessor(&per_cu, (const void*)fwd_kernel, 512, LDS_BYTES);
        if (per_cu < 1) { fprintf(stderr, "kernel_launch: occupancy query says %d blocks per CU\n", per_cu); per_cu = 1; }
        (void)hipGetLastError();
        grid = cus;
    }
    if (grid < 0) return;
    if (hipMemsetAsync((char*)d_ws + WS_BAR, 0, 16384, stream) != hipSuccess) { fprintf(stderr, "kernel_launch: memset failed\n"); return; }
    Args a{};
    const float** p = (const float**)&a;
    for (int i = 0; i < 26; ++i) p[i] = (const float*)d_in[i];
    a.out = (float*)d_out; a.ws = (unsigned char*)d_ws;
#if MK_SPLIT
    for (int ph = 0; ph < NPHASE; ++ph) { a.ph_lo = ph; a.ph_hi = ph + 1; hipLaunchKernelGGL(fwd_kernel, dim3(grid), dim3(512), LDS_BYTES, stream, a); }
#else
    a.ph_lo = 0; a.ph_hi = NPHASE;
    void* args[] = {&a};
    hipError_t e = hipLaunchCooperativeKernel((const void*)fwd_kernel, dim3(grid), dim3(512), args, LDS_BYTES, stream);
    if (e != hipSuccess) fprintf(stderr, "cooperative launch failed: %s (grid %d)\n", hipGetErrorString(e), grid);
#endif
}
```

```cpp
#include <hip/hip_runtime.h>
#include <hip/hip_cooperative_groups.h>
#include <cstdio>
#include <cstdint>
namespace cg = cooperative_groups;

#ifndef MK_SPLIT
#define MK_SPLIT 0
#endif

#ifndef REPMASK
#define REPMASK 0
#endif
#ifndef PHSEL
#define PHSEL(x) true
#endif
#define LAS __attribute__((address_space(3)))
__device__ __forceinline__ int opaque_tid() { int t = (int)threadIdx.x; asm volatile("" : "+v"(t)); return t; }
#define TIDX opaque_tid()
typedef unsigned short bf16;
typedef float f32x4 __attribute__((ext_vector_type(4)));
typedef short bf16x8 __attribute__((ext_vector_type(8)));
typedef short s16x4 __attribute__((ext_vector_type(4)));
typedef unsigned u32x4 __attribute__((ext_vector_type(4)));
typedef unsigned u32x2 __attribute__((ext_vector_type(2)));

__device__ __forceinline__ float bf2f(unsigned v) { return __uint_as_float(v << 16); }
__device__ __forceinline__ float bflo(unsigned w) { return __uint_as_float(w << 16); }
__device__ __forceinline__ float bfhi(unsigned w) { return __uint_as_float(w & 0xffff0000u); }
__device__ __forceinline__ unsigned f2bf(float f) { unsigned u = __float_as_uint(f); return (u + 0x7fffu + ((u >> 16) & 1u)) >> 16; }
typedef float f32x2_t __attribute__((ext_vector_type(2))); typedef __bf16 bf16x2_t __attribute__((ext_vector_type(2)));
__device__ __forceinline__ unsigned pk2(float lo, float hi) { f32x2_t v = {lo, hi}; bf16x2_t b = __builtin_convertvector(v, bf16x2_t); return __builtin_bit_cast(unsigned, b); }
__device__ __forceinline__ float frcp(float x) { return __builtin_amdgcn_rcpf(x); }
__device__ __forceinline__ float sigm(float x) { return frcp(1.f + __expf(-x)); }
__device__ __forceinline__ float silu_f(float x) { return x * sigm(x); }
__device__ __forceinline__ float gelu_f(float x) { return x * sigm(1.5957691216057308f * (x + 0.044715f * x * x * x)); }
__device__ __forceinline__ float wave_sum(float v) {
#pragma unroll
    for (int o = 1; o < 64; o <<= 1) v += __shfl_xor(v, o);
    return v;
}

namespace pg8 {
#define PG8_LAS __attribute__((address_space(3)))
typedef unsigned short bf16_t;
constexpr int BM = 256, BK = 64, HALF = 128, HTB = HALF * BK * 2, STAGE_BYTES = 8 * HTB, NXCD = 8, WGM = 8;
__host__ __device__ __forceinline__ int lds_byte(int r, int c) { const int st = (r >> 4) * 2 + (c >> 5), rr = r & 15, cc = c & 31, ob = rr * 64 + cc * 2; return st * 1024 + (ob ^ (((ob >> 9) & 1) << 5)); }
__host__ __device__ __forceinline__ void stage_rc(int b, int& R, int& C) { const int st = b / 1024, sb = b % 1024, swz = sb ^ (((sb >> 9) & 1) << 5); R = (st >> 1) * 16 + swz / 64; C = (st & 1) * 32 + (swz % 64) / 2; }
__host__ __device__ __forceinline__ int perm32(int rho) { const int n = rho >> 4, i = rho & 15; return 8 * (i >> 2) + 4 * n + (i & 3); }
struct Unit { int pm, pn; };
struct Gemm { const bf16_t* A; const bf16_t* Bt; int M, N, K; };
struct StaticOrder {
    int nM, nN, nwg, G, c;
    __host__ __device__ void init(int M, int N, int G_, int c_) { nM = M / BM; nN = N / BM; nwg = nM * nN; G = G_; c = c_; }
    __host__ __device__ bool next(int i, Unit& u) const {
        const long L = (long)i * G + c; if (L >= nwg) return false;
        int wgid = (int)L; { const int q = nwg / NXCD, r = nwg % NXCD, xcd = wgid % NXCD, off = wgid / NXCD; wgid = (xcd < r ? xcd * (q + 1) : r * (q + 1) + (xcd - r) * q) + off; }
        const int nig = WGM * nN, gid = wgid / nig, fm = gid * WGM, gsz = (nM - fm) < WGM ? (nM - fm) : WGM;
        u.pm = fm + ((wgid % nig) % gsz); u.pn = (wgid % nig) / gsz; return true;
    }
    __device__ __forceinline__ void a_ready(const Unit&) const {}
    __device__ __forceinline__ void done(const Unit&) const {}
};
struct TileOrder {
    int c, nch;
    __device__ bool next(int i, Unit& u) const {
        const int xcd = c & 7, slot = c >> 3; if (slot >= 20 || i >= nch) return false;
        const int L = xcd * 20 + slot; u.pm = i * 40 + (L >> 2); u.pn = i * 4 + (L & 3); return true;
    }
    __device__ __forceinline__ void a_ready(const Unit&) const {}
    __device__ __forceinline__ void done(const Unit&) const {}
};
__device__ __forceinline__ unsigned cvt_pk_bf16(float lo, float hi) { return pk2(lo, hi); }

struct EpiStore {
    static constexpr bool PERM = true, AFTER_DRAIN = false;
    bf16_t* O; int ldc;
    __device__ __forceinline__ bool zero_after(const Unit&) const { return true; }
    __device__ __forceinline__ void operator()(f32x4 (&acc)[2][2][4][2], const Unit& u, int wr, int wc, int fr, int fq) const {
        const int row0 = u.pm * BM + wr * 64 + fr, col0 = u.pn * BM + wc * 32 + 8 * fq;
#pragma unroll
        for (int ai = 0; ai < 2; ++ai)
#pragma unroll
            for (int m = 0; m < 4; ++m) { bf16_t* rowp = O + (size_t)(row0 + ai * HALF + m * 16) * ldc + col0;
#pragma unroll
                for (int bj = 0; bj < 2; ++bj) { const f32x4 v0 = acc[ai][bj][m][0], v1 = acc[ai][bj][m][1];
                    u32x4 w; w.x = cvt_pk_bf16(v0[0], v0[1]); w.y = cvt_pk_bf16(v0[2], v0[3]); w.z = cvt_pk_bf16(v1[0], v1[1]); w.w = cvt_pk_bf16(v1[2], v1[3]);
                    *(u32x4*)(rowp + bj * HALF) = w; } }
    }
};
struct EpiZ {
    static constexpr bool PERM = true, AFTER_DRAIN = false;
    bf16_t* O; int ldc; int plain;
    __device__ __forceinline__ bool zero_after(const Unit&) const { return true; }
    __device__ __forceinline__ void operator()(f32x4 (&acc)[2][2][4][2], const Unit& u, int wr, int wc, int fr, int fq) const {
        const int row0 = u.pm * BM + wr * 64 + fr, col0 = u.pn * BM + wc * 32 + 8 * fq;
        const int pn = u.pn;
        const int mode = plain ? 0 : pn < 2 ? 1 : (pn < 8 ? 0 : (pn < 10 ? 2 : (pn < 14 ? 3 : (pn < 16 ? 0 : 4))));
#pragma unroll
        for (int ai = 0; ai < 2; ++ai)
#pragma unroll
            for (int m = 0; m < 4; ++m) { bf16_t* rowp = O + (size_t)(row0 + ai * HALF + m * 16) * ldc + col0;
#pragma unroll
                for (int bj = 0; bj < 2; ++bj) { float v[8];
#pragma unroll
                    for (int e = 0; e < 4; ++e) { v[e] = acc[ai][bj][m][0][e]; v[4 + e] = acc[ai][bj][m][1][e]; }
                    if (mode == 1) {
#pragma unroll
                        for (int e = 0; e < 8; ++e) v[e] = v[e] * sigm(v[e]) * 0.08838834764831845f;
                    } else if (mode == 2) {
#pragma unroll
                        for (int e = 0; e < 8; ++e) v[e] = v[e] * sigm(v[e]);
                    } else if (mode == 3) {
#pragma unroll
                        for (int e = 0; e < 8; ++e) v[e] = gelu_f(v[e]);
                    } else if (mode == 4) {
#pragma unroll
                        for (int e = 0; e < 8; ++e) v[e] = sigm(v[e]);
                    }
                    u32x4 w; w.x = cvt_pk_bf16(v[0], v[1]); w.y = cvt_pk_bf16(v[2], v[3]); w.z = cvt_pk_bf16(v[4], v[5]); w.w = cvt_pk_bf16(v[6], v[7]);
                    *(u32x4*)(rowp + bj * HALF) = w; } }
    }
};
struct EpiResid {
    static constexpr bool PERM = true, AFTER_DRAIN = false;
    float* X; const float* gate;
    __device__ __forceinline__ bool zero_after(const Unit&) const { return true; }
    __device__ __forceinline__ void operator()(f32x4 (&acc)[2][2][4][2], const Unit& u, int wr, int wc, int fr, int fq) const {
        const int modrow = u.pm < 32 ? 0 : 1 + ((u.pm - 32) >> 2);
        const int row0 = u.pm * BM + wr * 64 + fr, col0 = u.pn * BM + wc * 32 + 8 * fq;
        const float* g = gate + modrow * 6144 + col0;
        f32x4 gv[2][2];
#pragma unroll
        for (int bj = 0; bj < 2; ++bj) { gv[bj][0] = *(const f32x4*)(g + bj * HALF); gv[bj][1] = *(const f32x4*)(g + bj * HALF + 4); }
#pragma unroll
        for (int ai = 0; ai < 2; ++ai) {
            f32x4 xv[4][2][2];
#pragma unroll
            for (int m = 0; m < 4; ++m) { const float* rowp = X + (size_t)(row0 + ai * HALF + m * 16) * 1024 + col0;
#pragma unroll
                for (int bj = 0; bj < 2; ++bj) { xv[m][bj][0] = *(const f32x4*)(rowp + bj * HALF); xv[m][bj][1] = *(const f32x4*)(rowp + bj * HALF + 4); } }
#pragma unroll
            for (int m = 0; m < 4; ++m) { float* rowp = X + (size_t)(row0 + ai * HALF + m * 16) * 1024 + col0;
#pragma unroll
                for (int bj = 0; bj < 2; ++bj) {
                    *(f32x4*)(rowp + bj * HALF) = xv[m][bj][0] + gv[bj][0] * acc[ai][bj][m][0]; *(f32x4*)(rowp + bj * HALF + 4) = xv[m][bj][1] + gv[bj][1] * acc[ai][bj][m][1]; } }
            asm volatile("" ::: "memory"); }
    }
};
struct EpiBranch {
    static constexpr bool PERM = true, AFTER_DRAIN = false;
    const bf16_t* Z; bf16_t* O;
    __device__ __forceinline__ bool zero_after(const Unit& u) const { return u.pm >= 80; }
    __device__ __forceinline__ void operator()(f32x4 (&acc)[2][2][4][2], const Unit& u, int wr, int wc, int fr, int fq) const {
        const int br = u.pm / 40, pm = u.pm - br * 40, pn = u.pn - br * 4;
        const int row0 = pm * BM + wr * 64 + fr, col0 = pn * BM + wc * 32 + 8 * fq;
#pragma unroll
        for (int ai = 0; ai < 2; ++ai) {
            u32x4 gcv[4][2], gnv[4][2];
#pragma unroll
            for (int m = 0; m < 4; ++m)
#pragma unroll
                for (int bj = 0; bj < 2; ++bj) { const bf16_t* zq_ = Z + (size_t)(row0 + ai * HALF + m * 16) * 7168 + 4096 + br * 1024 + col0 + bj * HALF;
                    gcv[m][bj] = *(const u32x4*)zq_; gnv[m][bj] = br < 2 ? *(const u32x4*)(zq_ + 1024) : (u32x4){0u, 0u, 0u, 0u}; }
#pragma unroll
            for (int m = 0; m < 4; ++m) { const int row = row0 + ai * HALF + m * 16;
#pragma unroll
                for (int bj = 0; bj < 2; ++bj) {
                    const bf16_t* zp = Z + (size_t)row * 7168 + 4096 + br * 1024 + col0 + bj * HALF;
                    const u32x4 gc = gcv[m][bj];
                    float f[8];
                    if (br < 2) { const u32x4 gn = gnv[m][bj];
#pragma unroll
                        for (int e = 0; e < 4; ++e) { f[2 * e] = bflo(gc[e]) * frcp(fmaxf(bflo(gn[e]), 1e-20f)); f[2 * e + 1] = bfhi(gc[e]) * frcp(fmaxf(bfhi(gn[e]), 1e-20f)); }
                    } else {
#pragma unroll
                        for (int e = 0; e < 4; ++e) { f[2 * e] = bflo(gc[e]); f[2 * e + 1] = bfhi(gc[e]); }
                    }
                    f32x4 v0 = acc[ai][bj][m][0], v1 = acc[ai][bj][m][1];
                    v0[0] *= f[0]; v0[1] *= f[1]; v0[2] *= f[2]; v0[3] *= f[3]; v1[0] *= f[4]; v1[1] *= f[5]; v1[2] *= f[6]; v1[3] *= f[7];
                    if (br < 2) { acc[ai][bj][m][0] = v0; acc[ai][bj][m][1] = v1; }
                    else { u32x4 w; w.x = cvt_pk_bf16(v0[0], v0[1]); w.y = cvt_pk_bf16(v0[2], v0[3]); w.z = cvt_pk_bf16(v1[0], v1[1]); w.w = cvt_pk_bf16(v1[2], v1[3]);
                        *(u32x4*)(O + (size_t)row * 1024 + col0 + bj * HALF) = w; }
                } } }
    }
};

template <class Epi, class Sched, bool ALIGN_EPI = false, bool SP2 = false>
__device__ __forceinline__ void gemm_phase(PG8_LAS unsigned char* lds, const Gemm g, const Sched& S, const Epi& E) {
    const int tid = TIDX, wid = __builtin_amdgcn_readfirstlane(tid >> 6), lane = tid & 63, wr = wid >> 2, wc = wid & 3, fr = lane & 15, fq = lane >> 4;
    const int K = g.K, nt = K / BK;
    unsigned voffA[2], voffB[2];
#pragma unroll
    for (int i = 0; i < 2; ++i) { int R, C; stage_rc(tid * 16 + i * 8192, R, C); const int Rb = Epi::PERM ? ((R & ~31) + perm32(R & 31)) : R;
        voffA[i] = (unsigned)(R * K + C) * 2u; voffB[i] = (unsigned)(Rb * K + C) * 2u; }
    const size_t kstep = (size_t)(BK * 2);
    const size_t hstep = (size_t)HALF * K * 2;
    const size_t tstep = 2 * hstep;
    const unsigned ldsw = (unsigned)wid * 1024u;
    const int aoff = lds_byte(wr * 64 + fr, fq * 8), boff = lds_byte(wc * 32 + fr, fq * 8);
#define PG8_SA(b, h) (((b) * 2 + (h)) * HTB)
#define PG8_SB(b, h) ((4 + (b) * 2 + (h)) * HTB)
#define PG8_STAGE(bufoff, gbase, voff) do { _Pragma("unroll") for (int _i = 0; _i < 2; ++_i) \
        __builtin_amdgcn_global_load_lds((const unsigned*)((const char*)(gbase) + (voff)[_i]), (PG8_LAS unsigned*)(lds + (bufoff) + ldsw + _i * 8192), 16, 0, 0); } while (0)
#define PG8_LDA(dst, b, h) do { _Pragma("unroll") for (int m = 0; m < 4; ++m) _Pragma("unroll") for (int k = 0; k < 2; ++k) dst[m][k] = *(const PG8_LAS bf16x8*)(lds + PG8_SA(b, h) + aoff + m * 2048 + k * 1024); } while (0)
#define PG8_LDB(dst, b, h) do { _Pragma("unroll") for (int n = 0; n < 2; ++n) _Pragma("unroll") for (int k = 0; k < 2; ++k) dst[n][k] = *(const PG8_LAS bf16x8*)(lds + PG8_SB(b, h) + boff + n * 2048 + k * 1024); } while (0)
#define PG8_MMA(ai, bj, At, Bt) do { __builtin_amdgcn_s_setprio(1); _Pragma("unroll") for (int m = 0; m < 4; ++m) _Pragma("unroll") for (int n = 0; n < 2; ++n) _Pragma("unroll") for (int k = 0; k < 2; ++k) \
        acc[ai][bj][m][n] = __builtin_amdgcn_mfma_f32_16x16x32_bf16(Bt[n][k], At[m][k], acc[ai][bj][m][n], 0, 0, 0); __builtin_amdgcn_s_setprio(0); } while (0)
#define PG8_WAIT_V(n) asm volatile("s_waitcnt vmcnt(" #n ")" ::: "memory")
#define PG8_WAIT_L(n) asm volatile("s_waitcnt lgkmcnt(" #n ")" ::: "memory")
#define PG8_BAR __builtin_amdgcn_s_barrier()
#define PG8_SCHED __builtin_amdgcn_sched_barrier(0)
    Unit cur, nxt; int ui = 0;
    if (!S.next(0, cur)) return;
    f32x4 acc[2][2][4][2];
#pragma unroll
    for (int a = 0; a < 2; ++a)
#pragma unroll
        for (int b = 0; b < 2; ++b)
#pragma unroll
            for (int m = 0; m < 4; ++m)
#pragma unroll
                for (int n = 0; n < 2; ++n) acc[a][b][m][n] = (f32x4){0.f, 0.f, 0.f, 0.f};
    bf16x8 At[4][2], B0[2][2], B1[2][2];
    const char* cA = (const char*)g.A + (size_t)cur.pm * tstep; const char* cB = (const char*)g.Bt + (size_t)cur.pn * tstep;
    S.a_ready(cur);
    if constexpr (SP2) {
        PG8_STAGE(PG8_SB(0, 0), cB, voffB); PG8_STAGE(PG8_SB(0, 1), cB + hstep, voffB); PG8_STAGE(PG8_SA(0, 0), cA, voffA); PG8_STAGE(PG8_SA(0, 1), cA + hstep, voffA);
        if (wr == 1) PG8_BAR;
        PG8_WAIT_V(2); PG8_BAR;
        PG8_STAGE(PG8_SB(1, 0), cB + kstep, voffB); PG8_STAGE(PG8_SA(1, 0), cA + kstep, voffA); PG8_STAGE(PG8_SB(1, 1), cB + hstep + kstep, voffB);
        PG8_WAIT_V(6); PG8_BAR;
    } else {
        PG8_STAGE(PG8_SB(0, 0), cB, voffB); PG8_STAGE(PG8_SA(0, 0), cA, voffA); PG8_STAGE(PG8_SB(0, 1), cB + hstep, voffB); PG8_STAGE(PG8_SA(0, 1), cA + hstep, voffA);
        if (wr == 1) PG8_BAR;
        PG8_WAIT_V(4); PG8_BAR;
        PG8_STAGE(PG8_SB(1, 0), cB + kstep, voffB); PG8_STAGE(PG8_SA(1, 0), cA + kstep, voffA); PG8_STAGE(PG8_SB(1, 1), cB + hstep + kstep, voffB);
        PG8_WAIT_V(6); PG8_BAR;
    }
    for (;;) {
        const bool has_next = S.next(ui + 1, nxt);
        const char* nA = has_next ? (const char*)g.A + (size_t)nxt.pm * tstep : cA; const char* nB = has_next ? (const char*)g.Bt + (size_t)nxt.pn * tstep : cB;
        for (int t = 0; t < nt; t += 2) {
            const bool last = (t == nt - 2);
            const char* a1 = cA + (size_t)(t + 1) * kstep;
            const char* a2 = last ? nA : cA + (size_t)(t + 2) * kstep; const char* b2 = last ? nB : cB + (size_t)(t + 2) * kstep;
            const char* a3 = a2 + kstep; const char* b3 = b2 + kstep;
            if (last && has_next) S.a_ready(nxt);
            if constexpr (SP2) {
            PG8_LDB(B0, 0, 0); PG8_LDB(B1, 0, 1); PG8_SCHED; PG8_LDA(At, 0, 0); PG8_STAGE(PG8_SA(1, 1), a1 + hstep, voffA);
            PG8_WAIT_V(8); PG8_WAIT_L(0); PG8_BAR; PG8_MMA(0, 0, At, B0); PG8_MMA(0, 1, At, B1); PG8_BAR; PG8_SCHED;
            PG8_LDA(At, 0, 1); PG8_STAGE(PG8_SB(0, 0), b2, voffB); PG8_STAGE(PG8_SB(0, 1), b2 + hstep, voffB); PG8_STAGE(PG8_SA(0, 0), a2, voffA);
            PG8_WAIT_V(8); PG8_WAIT_L(0); PG8_BAR; PG8_MMA(1, 0, At, B0); PG8_MMA(1, 1, At, B1); PG8_BAR; PG8_SCHED;
            PG8_LDB(B0, 1, 0); PG8_LDB(B1, 1, 1); PG8_SCHED; PG8_LDA(At, 1, 0); PG8_STAGE(PG8_SA(0, 1), a2 + hstep, voffA);
            PG8_WAIT_V(8); PG8_WAIT_L(0); PG8_BAR; PG8_MMA(0, 0, At, B0); PG8_MMA(0, 1, At, B1); PG8_BAR; PG8_SCHED;
            PG8_LDA(At, 1, 1); PG8_STAGE(PG8_SB(1, 0), b3, voffB); PG8_STAGE(PG8_SB(1, 1), b3 + hstep, voffB); PG8_STAGE(PG8_SA(1, 0), a3, voffA);
            PG8_WAIT_V(8); PG8_WAIT_L(0); PG8_BAR; PG8_MMA(1, 0, At, B0); PG8_MMA(1, 1, At, B1); PG8_BAR; PG8_SCHED;
            } else {
            PG8_LDB(B0, 0, 0); PG8_SCHED; PG8_LDA(At, 0, 0); PG8_STAGE(PG8_SA(1, 1), a1 + hstep, voffA);
            PG8_WAIT_L(8); PG8_BAR; PG8_WAIT_L(0); PG8_MMA(0, 0, At, B0); PG8_BAR; PG8_SCHED;
            PG8_LDB(B1, 0, 1); PG8_STAGE(PG8_SB(0, 0), b2, voffB);
            PG8_BAR; PG8_WAIT_L(0); PG8_MMA(0, 1, At, B1); PG8_BAR;
            PG8_LDA(At, 0, 1); PG8_STAGE(PG8_SA(0, 0), a2, voffA);
            PG8_BAR; PG8_WAIT_L(0); PG8_MMA(1, 0, At, B0); PG8_BAR; PG8_SCHED;
            PG8_STAGE(PG8_SB(0, 1), b2 + hstep, voffB);
            PG8_WAIT_V(6); PG8_BAR; PG8_MMA(1, 1, At, B1); PG8_BAR;
            PG8_LDB(B0, 1, 0); PG8_SCHED; PG8_LDA(At, 1, 0); PG8_STAGE(PG8_SA(0, 1), a2 + hstep, voffA);
            PG8_WAIT_L(8); PG8_BAR; PG8_WAIT_L(0); PG8_MMA(0, 0, At, B0); PG8_BAR; PG8_SCHED;
            PG8_LDB(B1, 1, 1); PG8_STAGE(PG8_SB(1, 0), b3, voffB);
            PG8_BAR; PG8_WAIT_L(0); PG8_MMA(0, 1, At, B1); PG8_BAR;
            PG8_LDA(At, 1, 1); PG8_STAGE(PG8_SA(1, 0), a3, voffA);
            PG8_BAR; PG8_WAIT_L(0); PG8_MMA(1, 0, At, B0); PG8_BAR; PG8_SCHED;
            PG8_STAGE(PG8_SB(1, 1), b3 + hstep, voffB);
            PG8_WAIT_V(6); PG8_BAR; PG8_MMA(1, 1, At, B1); PG8_BAR;
            }
        }
        if constexpr (ALIGN_EPI) { if (wr == 0) PG8_BAR; }
        E(acc, cur, wr, wc, fr, fq);
        if (!has_next) break;
        if (E.zero_after(cur)) {
#pragma unroll
        for (int a = 0; a < 2; ++a)
#pragma unroll
            for (int b = 0; b < 2; ++b)
#pragma unroll
                for (int m = 0; m < 4; ++m)
#pragma unroll
                    for (int n = 0; n < 2; ++n) acc[a][b][m][n] = (f32x4){0.f, 0.f, 0.f, 0.f};
        }
        cur = nxt; cA = nA; cB = nB; ++ui;
        if constexpr (ALIGN_EPI) { if (wr == 1) PG8_BAR; }
    }
    PG8_WAIT_V(0);
    if constexpr (!ALIGN_EPI) { if (wr == 0) PG8_BAR; }
    PG8_BAR;

#undef PG8_SA
#undef PG8_SB
#undef PG8_STAGE
#undef PG8_LDA
#undef PG8_LDB
#undef PG8_MMA
#undef PG8_WAIT_V
#undef PG8_WAIT_L
#undef PG8_BAR
#undef PG8_SCHED
}
}

constexpr int D = 1024, MP = 8192, M = 10240, NZ = 7168, DFF = 2816, NUP = 5632, NMOD = 6144;
constexpr int ZQ = 0, ZFF = 512, ZI = 1536, ZG = 2048, ZU = 2560, ZV = 3072, ZP = 3584;
constexpr float EPS = 1e-6f;
constexpr size_t MiB = 1u << 20;
constexpr size_t WS_BAR = 512 * 1024, WS_MOD = 0, WS_WIN = 1 * MiB, WS_WBR = 15 * MiB, WS_WOUT = 18 * MiB, WS_WUP = 20 * MiB, WS_WDN = 31 * MiB, WS_H = 37 * MiB, WS_Z = 57 * MiB, WS_O3 = 197 * MiB, WS_END = 252 * MiB;
constexpr size_t WS_SL = WS_O3 + 30 * MiB, WS_QC = WS_O3 + 34 * MiB, WS_AS = WS_O3 + 38 * MiB;
constexpr int LDS_BYTES = 147456;
constexpr int NPHASE = 22;

struct Args {
    const float *x_prompt, *x_sample, *c, *state, *c_ctx, *norm_mix, *norm_ffn, *w_ada, *b_ada, *w_in, *lb_logits, *hg_norm, *w_br_hg, *w_br_sg, *w_br_pool, *w_out,
        *sg_norm, *sg_w, *sg_b, *pool_w, *pool_scale, *ffn_up, *conv_w, *conv_b, *ffn_down, *final_norm;
    float* out; unsigned char* ws; int ph_lo, ph_hi;
};

__device__ __forceinline__ void transpose_item(const float* W, int K, int N, bf16* WT, LAS float* scr, int item, int lane) {
    const int nblk = N / 32, kb = item / nblk, nb = item % nblk, k0 = 64 * kb, n0 = 32 * nb;
    float wv[32];
#pragma unroll
    for (int i = 0; i < 32; ++i) wv[i] = W[(size_t)(k0 + 2 * i + (lane >> 5)) * N + n0 + (lane & 31)];
#pragma unroll
    for (int i = 0; i < 32; ++i) scr[(2 * i + (lane >> 5)) * 33 + (lane & 31)] = wv[i];
    asm volatile("s_waitcnt lgkmcnt(0)" ::: "memory");
    const int c = lane & 7;
#pragma unroll
    for (int j = 0; j < 4; ++j) { const int n = (lane >> 3) + 8 * j; const LAS float* s = scr + (8 * c) * 33 + n;
        u32x4 o; o.x = pk2(s[0 * 33], s[1 * 33]); o.y = pk2(s[2 * 33], s[3 * 33]); o.z = pk2(s[4 * 33], s[5 * 33]); o.w = pk2(s[6 * 33], s[7 * 33]);
        *(u32x4*)(WT + (size_t)(n0 + n) * K + k0 + 8 * c) = o; }
    asm volatile("s_waitcnt lgkmcnt(0)" ::: "memory");
}
__device__ __forceinline__ void convert_set(const Args& a, LAS unsigned char* lds, int l, int mask, int wid, int nw) {
    const int lane = TIDX & 63, wave = TIDX >> 6;
    LAS float* scr = (LAS float*)(lds + wave * 16384);
    unsigned char* ws = a.ws;
    const int I_IN = (mask & 1) ? (D / 64) * (NZ / 32) : 0, I_B0 = (mask & 2) ? (512 / 64) * (D / 32) : 0, I_B1 = (mask & 4) ? (512 / 64) * (D / 32) : 0, I_B2 = (mask & 8) ? (512 / 64) * (D / 32) : 0;
    const int I_OUT = (mask & 16) ? (D / 64) * (D / 32) : 0, I_UP = (mask & 32) ? (D / 64) * (NUP / 32) : 0, I_DN = (mask & 64) ? (DFF / 64) * (D / 32) : 0;
    const int NITEMS = I_IN + I_B0 + I_B1 + I_B2 + I_OUT + I_UP + I_DN;
    for (int it = wid; it < NITEMS; it += nw) {
        int r = it;
        if (r < I_IN) { transpose_item(a.w_in + (size_t)l * D * NZ, D, NZ, (bf16*)(ws + WS_WIN), scr, r, lane); continue; } r -= I_IN;
        if (r < I_B0) { transpose_item(a.w_br_hg + (size_t)l * 512 * D, 512, D, (bf16*)(ws + WS_WBR), scr, r, lane); continue; } r -= I_B0;
        if (r < I_B1) { transpose_item(a.w_br_sg + (size_t)l * 512 * D, 512, D, (bf16*)(ws + WS_WBR) + 1024 * 512, scr, r, lane); continue; } r -= I_B1;
        if (r < I_B2) { transpose_item(a.w_br_pool + (size_t)l * 512 * D, 512, D, (bf16*)(ws + WS_WBR) + 2 * 1024 * 512, scr, r, lane); continue; } r -= I_B2;
        if (r < I_OUT) { transpose_item(a.w_out + (size_t)l * D * D, D, D, (bf16*)(ws + WS_WOUT), scr, r, lane); continue; } r -= I_OUT;
        if (r < I_UP) { transpose_item(a.ffn_up + (size_t)l * D * NUP, D, NUP, (bf16*)(ws + WS_WUP), scr, r, lane); continue; } r -= I_UP;
        transpose_item(a.ffn_down + (size_t)l * DFF * D, DFF, D, (bf16*)(ws + WS_WDN), scr, r, lane);
    }
}
__device__ __forceinline__ void phase_mods(const Args& a, LAS unsigned char* lds) {
    const int tid = TIDX;
    LAS float* sc = (LAS float*)lds;
    LAS float* red = (LAS float*)(lds + 12288);
    float* mods = (float*)(a.ws + WS_MOD);
    for (int blk = blockIdx.x; blk < 256; blk += gridDim.x) {
        const int l = blk >> 7, n0 = (blk & 127) * 48;
        for (int i = tid; i < 3072; i += 512) { const int r = i >> 10, k = i & 1023; const float v = r == 0 ? a.c_ctx[k] : a.c[(r - 1) * 1024 + k]; sc[i] = silu_f(v); }
        __syncthreads();
        const int ks = tid / 12, c4 = tid - ks * 12;
        if (ks < 42) {
            const float* W = a.w_ada + (size_t)l * D * NMOD + n0 + 4 * c4;
            f32x4 a0 = (f32x4){0.f, 0.f, 0.f, 0.f}, a1 = a0, a2 = a0;
#pragma unroll 5
            for (int k = ks; k < 1024; k += 42) { const f32x4 wv = *(const f32x4*)(W + (size_t)k * NMOD); a0 += wv * sc[k]; a1 += wv * sc[1024 + k]; a2 += wv * sc[2048 + k]; }
            *(LAS f32x4*)(red + (ks * 3 + 0) * 48 + 4 * c4) = a0; *(LAS f32x4*)(red + (ks * 3 + 1) * 48 + 4 * c4) = a1; *(LAS f32x4*)(red + (ks * 3 + 2) * 48 + 4 * c4) = a2;
        }
        __syncthreads();
        if (tid < 144) { const int r = tid / 48, cc = tid - r * 48; float sm = 0.f;
            for (int w = 0; w < 42; ++w) sm += red[(w * 3 + r) * 48 + cc];
            mods[(l * 3 + r) * NMOD + n0 + cc] = sm + a.b_ada[l * NMOD + n0 + cc]; }
        __syncthreads();
    }
}
__device__ __forceinline__ void phase_norm(const Args& a, int l, const float* gain, int shift_off, bool first) {
    const int lane = TIDX & 63, wave = TIDX >> 6;
    const int gw = blockIdx.x * 8 + wave, NGW = gridDim.x * 8;
    const float* mods = (const float*)(a.ws + WS_MOD) + (size_t)l * 3 * NMOD;
    bf16* H = (bf16*)(a.ws + WS_H);
    f32x4 gn[4];
#pragma unroll
    for (int j = 0; j < 4; ++j) gn[j] = *(const f32x4*)(gain + 4 * (lane + 64 * j));
    for (int row = gw; row < M; row += NGW) {
        const int modrow = row < MP ? 0 : 1 + ((row - MP) >> 10);
        const float* src = first ? (row < MP ? a.x_prompt + (size_t)row * D : a.x_sample + (size_t)(row - MP) * D) : a.out + (size_t)row * D;
        f32x4 v[4]; float s = 0.f;
#pragma unroll
        for (int j = 0; j < 4; ++j) v[j] = *(const f32x4*)(src + 4 * (lane + 64 * j));
        if (first) {
            if (row >= MP) {
                const int n = (row - MP) & 1023; const float pr = (float)(n >> 6), pc = (float)(n & 63);
#pragma unroll
                for (int e = 0; e < 4; ++e) { const float om = expf(-(float)(4 * lane + e) * (9.210340371976184f / 256.f));
                    v[0][e] += sinf(pr * om); v[1][e] += cosf(pr * om); v[2][e] += sinf(pc * om); v[3][e] += cosf(pc * om); }
            }
#pragma unroll
            for (int j = 0; j < 4; ++j) *(f32x4*)(a.out + (size_t)row * D + 4 * (lane + 64 * j)) = v[j];
        }
#pragma unroll
        for (int j = 0; j < 4; ++j) s += (v[j][0] * v[j][0] + v[j][1] * v[j][1]) + (v[j][2] * v[j][2] + v[j][3] * v[j][3]);
        const float rstd = rsqrtf(wave_sum(s) * (1.f / D) + EPS);
        const float* mr = mods + modrow * NMOD + shift_off;
#pragma unroll
        for (int j = 0; j < 4; ++j) { const int c0 = 4 * (lane + 64 * j);
            const f32x4 sh = *(const f32x4*)(mr + c0), scl = *(const f32x4*)(mr + 1024 + c0);
            const f32x4 y = v[j] * rstd * gn[j] * (scl + 1.f) + sh;
            u32x2 o; o.x = pk2(y[0], y[1]); o.y = pk2(y[2], y[3]);
            *(u32x2*)(H + (size_t)row * D + c0) = o; }
    }
}
__device__ __forceinline__ void phase_final(const Args& a) {
    const int lane = TIDX & 63, wave = TIDX >> 6;
    const int gw = blockIdx.x * 8 + wave, NGW = gridDim.x * 8;
    f32x4 gn[4];
#pragma unroll
    for (int j = 0; j < 4; ++j) gn[j] = *(const f32x4*)(a.final_norm + 4 * (lane + 64 * j));
    for (int row = gw; row < M; row += NGW) {
        float* xr = a.out + (size_t)row * D;
        f32x4 v[4]; float s = 0.f;
#pragma unroll
        for (int j = 0; j < 4; ++j) { v[j] = *(const f32x4*)(xr + 4 * (lane + 64 * j)); s += (v[j][0] * v[j][0] + v[j][1] * v[j][1]) + (v[j][2] * v[j][2] + v[j][3] * v[j][3]); }
        const float rstd = rsqrtf(wave_sum(s) * (1.f / D) + EPS);
#pragma unroll
        for (int j = 0; j < 4; ++j) *(f32x4*)(xr + 4 * (lane + 64 * j)) = v[j] * rstd * gn[j];
    }
}

constexpr int SC_QT = 0, SC_KT = 4352, SC_QD = 8704, SC_KE = 13056, SC_VT = 18176, SC_AD = 23296, SC_BUF = 23808, SC_TOT = 2 * SC_BUF;
__device__ __forceinline__ s16x4 pack4(f32x4 v) { u32x2 p; p.x = pk2(v[0], v[1]); p.y = pk2(v[2], v[3]); return __builtin_bit_cast(s16x4, p); }
__device__ __forceinline__ void scan_item(const Args& a, LAS unsigned char* lds, int l, int s, int h, int d, int seg) {
    const int tid = TIDX, lane = tid & 63, w = tid >> 6, fr = lane & 15, fq = lane >> 4;
    const int k = (w & 1) * 64 + lane, tg = w >> 1;
    const int T = s < 32 ? 256 : 1024, base = s < 32 ? s * 256 : MP + (s - 32) * 1024, nch = 16, pos0 = 256 * seg;
    const bf16* Z = (const bf16*)(a.ws + WS_Z);
    bf16* OH = (bf16*)(a.ws + WS_H) + (size_t)d * M * 512;
    const int sidx = (((s - 32) * 4 + h) * 2 + d) * 4 + seg;
    bf16* QC = (bf16*)(a.ws + WS_QC) + (size_t)((((s - 32) * 4 + h) * 2 + d) * 1024) * 128;
    float run = 1.f;
    float lb = 0.f;
    if (l == 1) lb = sigm(a.lb_logits[(2 + d) * 512 + h * 128 + k] - a.lb_logits[d * 512 + h * 128 + k]);
    const float oml = 1.f - lb;
    f32x4 S[8];
    if (s >= 32 && seg == 0) { const float* st = a.state + ((((size_t)(s - 32) * 2 + l) * 2 + d) * 4 + h) * 16384;
#pragma unroll
        for (int r = 0; r < 8; ++r)
#pragma unroll
            for (int i = 0; i < 4; ++i) S[r][i] = st[(16 * r + 4 * fq + i) * 128 + 16 * w + fr];
    } else {
#pragma unroll
        for (int r = 0; r < 8; ++r) S[r] = (f32x4){0.f, 0.f, 0.f, 0.f};
    }
    LAS float* TOT = (LAS float*)(lds + SC_TOT);
    const int zcol_q = ZQ + h * 128 + k, zcol_f = ZFF + d * 512 + h * 128 + k, zcol_i = ZI + h * 128 + k;
    unsigned short nq[4], nf[4], ni[4];
#define SC_TOK(c, j) (d == 0 ? pos0 + 16 * (c) + (j) : T - 1 - pos0 - 16 * (c) - (j))
#define SC_ROW(c, j) (base + SC_TOK(c, j))
#define SC_BAR() do { asm volatile("s_waitcnt lgkmcnt(0)" ::: "memory"); __builtin_amdgcn_s_barrier(); asm volatile("" ::: "memory"); } while (0)
#pragma unroll
    for (int e = 0; e < 4; ++e) { const size_t ro = (size_t)SC_ROW(0, 4 * tg + e) * NZ; nq[e] = Z[ro + zcol_q]; nf[e] = Z[ro + zcol_f]; ni[e] = Z[ro + zcol_i]; }
    {
      for (int c = 0; c < nch; ++c) {
        float q[4], kk[4], pf[4], vv[4];
#pragma unroll
        for (int e = 0; e < 4; ++e) {
            const float zf = fmaxf(bf2f(nf[e]), -30.f), ex = __expf(-zf), sg = frcp(1.f + ex);
            pf[e] = lb + oml * sg; kk[e] = oml * ex * sg; q[e] = bf2f(nq[e]); vv[e] = bf2f(ni[e]);
        }
        if (c + 1 < nch) {
#pragma unroll
            for (int e = 0; e < 4; ++e) { const size_t ro = (size_t)SC_ROW(c + 1, 4 * tg + e) * NZ; nq[e] = Z[ro + zcol_q]; nf[e] = Z[ro + zcol_f]; ni[e] = Z[ro + zcol_i]; }
        }
        pf[1] *= pf[0]; pf[2] *= pf[1]; pf[3] *= pf[2];
        TOT[tg * 128 + k] = pf[3];
        SC_BAR();
        const float t0 = TOT[k], t1 = TOT[128 + k], t2 = TOT[256 + k], t3 = TOT[384 + k];
        const float off = (tg > 0 ? t0 : 1.f) * (tg > 1 ? t1 : 1.f) * (tg > 2 ? t2 : 1.f), pref = t0 * t1, p15 = pref * (t2 * t3);
        const float ipref = frcp(fmaxf(pref, 1e-30f));
        LAS unsigned char* B = lds + (c & 1) * SC_BUF;
        float ke[4];
#pragma unroll
        for (int e = 0; e < 4; ++e) { const float P = off * pf[e], iP = frcp(fmaxf(P, 1e-30f)); const int j = 4 * tg + e;
            const unsigned w0 = pk2(q[e] * (P * ipref), kk[e] * (pref * iP)), w1 = pk2(q[e] * P, 0.f);
            ((LAS bf16*)(B + SC_QT))[j * 136 + k] = (bf16)(w0 & 0xffffu);
            ((LAS bf16*)(B + SC_KT))[j * 136 + k] = (bf16)(w0 >> 16);
            ((LAS bf16*)(B + SC_QD))[j * 136 + k] = (bf16)(w1 & 0xffffu);
            if (s >= 32) QC[(size_t)SC_TOK(c, j) * 128 + k] = (bf16)(pk2(q[e] * P * run, 0.f) & 0xffffu);
            ke[e] = kk[e] * (p15 * iP); }
        run *= p15;
        { u32x2 p; p.x = pk2(ke[0], ke[1]); p.y = pk2(ke[2], ke[3]); *(LAS u32x2*)(B + SC_KE + k * 40 + tg * 8) = p;
          p.x = pk2(vv[0], vv[1]); p.y = pk2(vv[2], vv[3]); *(LAS u32x2*)(B + SC_VT + k * 40 + tg * 8) = p; }
        if (tg == 0) ((LAS float*)(B + SC_AD))[k] = p15;
        SC_BAR();
        f32x4 pt = (f32x4){0.f, 0.f, 0.f, 0.f};
#pragma unroll
        for (int k4 = 0; k4 < 4; ++k4) {
            const bf16x8 ka = *(const LAS bf16x8*)(B + SC_KT + fr * 272 + k4 * 64 + fq * 16);
            const bf16x8 qb = *(const LAS bf16x8*)(B + SC_QT + fr * 272 + k4 * 64 + fq * 16);
            pt = __builtin_amdgcn_mfma_f32_16x16x32_bf16(ka, qb, pt, 0, 0, 0);
        }
#pragma unroll
        for (int i = 0; i < 4; ++i) if (4 * fq + i > fr) pt[i] = 0.f;
        const s16x4 pa = pack4(pt);
        const s16x4 vb = *(const LAS s16x4*)(B + SC_VT + (16 * w + fr) * 40 + fq * 8);
        f32x4 o = __builtin_amdgcn_mfma_f32_16x16x16bf16_1k(pa, vb, (f32x4){0.f, 0.f, 0.f, 0.f}, 0, 0, 0);
#pragma unroll
        for (int r = 0; r < 8; ++r) {
            const s16x4 qa = *(const LAS s16x4*)(B + SC_QD + fr * 272 + r * 32 + fq * 8);
            o = __builtin_amdgcn_mfma_f32_16x16x16bf16_1k(qa, pack4(S[r]), o, 0, 0, 0);
        }
#pragma unroll
        for (int r = 0; r < 8; ++r) {
            const f32x4 ad = *(const LAS f32x4*)(B + SC_AD + (16 * r + 4 * fq) * 4);
            const s16x4 ka = *(const LAS s16x4*)(B + SC_KE + (16 * r + fr) * 40 + fq * 8);
            S[r] = __builtin_amdgcn_mfma_f32_16x16x16bf16_1k(ka, vb, S[r] * ad, 0, 0, 0);
        }
#pragma unroll
        for (int i = 0; i < 4; ++i) OH[(size_t)SC_ROW(c, 4 * fq + i) * 512 + h * 128 + 16 * w + fr] = (bf16)(pk2(o[i], 0.f) & 0xffffu);
      }
    }
#undef SC_ROW
#undef SC_TOK
#undef SC_BAR
    if (s >= 32) { float* sl = (float*)(a.ws + WS_SL) + (size_t)sidx * 16384;
#pragma unroll
        for (int r = 0; r < 8; ++r)
#pragma unroll
            for (int i = 0; i < 4; ++i) sl[(16 * r + 4 * fq + i) * 128 + 16 * w + fr] = S[r][i];
        if (tg == 0) ((float*)(a.ws + WS_AS))[sidx * 128 + k] = run; }
    if (s < 32) { float* st = a.out + (size_t)M * D + ((((size_t)s * 2 + l) * 2 + d) * 4 + h) * 16384;
#pragma unroll
        for (int r = 0; r < 8; ++r)
#pragma unroll
            for (int i = 0; i < 4; ++i) st[(16 * r + 4 * fq + i) * 128 + 16 * w + fr] = S[r][i]; }
    __syncthreads();
}
__device__ __forceinline__ void mm128(const LAS bf16* As, const LAS bf16* Bs, f32x4 (&acc)[2][4], int wr, int wc, int fr, int fq, bool zero = true) {
    if (zero) {
#pragma unroll
    for (int mt = 0; mt < 2; ++mt)
#pragma unroll
        for (int nt = 0; nt < 4; ++nt) acc[mt][nt] = (f32x4){0.f, 0.f, 0.f, 0.f}; }
#pragma unroll
    for (int k4 = 0; k4 < 4; ++k4) {
        bf16x8 af[2];
#pragma unroll
        for (int mt = 0; mt < 2; ++mt) af[mt] = *(const LAS bf16x8*)(As + (32 * wr + 16 * mt + fr) * 136 + 32 * k4 + 8 * fq);
#pragma unroll
        for (int nt = 0; nt < 4; ++nt) {
            const bf16x8 bfr = *(const LAS bf16x8*)(Bs + (64 * wc + 16 * nt + fr) * 136 + 32 * k4 + 8 * fq);
#pragma unroll
            for (int mt = 0; mt < 2; ++mt) acc[mt][nt] = __builtin_amdgcn_mfma_f32_16x16x32_bf16(af[mt], bfr, acc[mt][nt], 0, 0, 0);
        }
    }
}
__device__ __forceinline__ void stage_f32_tile(const float* W, LAS bf16* T) {
#pragma unroll
    for (int it = 0; it < 8; ++it) { const int idx = TIDX * 4 + 2048 * it, r = idx >> 7, cc = idx & 127;
        const f32x4 v = *(const f32x4*)(W + idx); u32x2 o; o.x = pk2(v[0], v[1]); o.y = pk2(v[2], v[3]); *(LAS u32x2*)(T + r * 136 + cc) = o; }
}
__device__ __forceinline__ void stage_f32_tile_T(const float* W, LAS bf16* T) {
#pragma unroll
    for (int it = 0; it < 4; ++it) { const int p = TIDX + 512 * it, n = p & 127, k0 = (p >> 7) * 8;
        float v[8];
#pragma unroll
        for (int e = 0; e < 8; ++e) v[e] = W[(size_t)(k0 + e) * 128 + n];
        u32x4 o; o.x = pk2(v[0], v[1]); o.y = pk2(v[2], v[3]); o.z = pk2(v[4], v[5]); o.w = pk2(v[6], v[7]);
        *(LAS u32x4*)(T + n * 136 + k0) = o; }
}
__device__ __forceinline__ void sg_item(const Args& a, LAS unsigned char* lds, int l, int ci) {
    const int tid = TIDX, lane = tid & 63, w = tid >> 6, fr = lane & 15, fq = lane >> 4, wr = w >> 1, wc = w & 1;
    const int r0 = ci * 128;
    const bf16* Z = (const bf16*)(a.ws + WS_Z);
    bf16* O = (bf16*)(a.ws + WS_O3) + (size_t)M * 512;
    LAS bf16* As = (LAS bf16*)lds; LAS bf16* Bs = (LAS bf16*)(lds + 34816); LAS float* rstd = (LAS float*)(lds + 69632);
    { u32x4 zz[16];
#pragma unroll
      for (int rr = 0; rr < 16; ++rr) zz[rr] = *(const u32x4*)(Z + (size_t)(r0 + 16 * w + rr) * NZ + ZV + 8 * lane);
#pragma unroll
      for (int rr = 0; rr < 16; ++rr) { float ss = 0.f;
#pragma unroll
        for (int e = 0; e < 4; ++e) { const float g0 = bflo(zz[rr][e]), g1 = bfhi(zz[rr][e]); ss += g0 * g0 + g1 * g1; }
        ss = wave_sum(ss); if (lane == 0) rstd[16 * w + rr] = rsqrtf(ss * (1.f / 512.f) + EPS); } }
    __syncthreads();
    f32x4 ra[8]; unsigned short rb[4][8]; float rgn[4];
#define SG_PREFETCH(gg) do { \
        _Pragma("unroll") for (int it = 0; it < 8; ++it) ra[it] = *(const f32x4*)(a.sg_w + ((size_t)l * 4 + (gg)) * 16384 + tid * 4 + 2048 * it); \
        _Pragma("unroll") for (int it = 0; it < 4; ++it) { const int p = tid + 512 * it, c = p & 127, s0 = (p >> 7) * 8; rgn[it] = a.sg_norm[l * 512 + (gg) * 128 + c]; \
            _Pragma("unroll") for (int e = 0; e < 8; ++e) rb[it][e] = Z[(size_t)(r0 + s0 + e) * NZ + ZV + (gg) * 128 + c]; } } while (0)
    SG_PREFETCH(0);
    for (int g = 0; g < 4; ++g) {
#pragma unroll
        for (int it = 0; it < 8; ++it) { const int idx = tid * 4 + 2048 * it, r = idx >> 7, cc = idx & 127;
            u32x2 o; o.x = pk2(ra[it][0], ra[it][1]); o.y = pk2(ra[it][2], ra[it][3]); *(LAS u32x2*)(As + r * 136 + cc) = o; }
#pragma unroll
        for (int it = 0; it < 4; ++it) { const int p = tid + 512 * it, c = p & 127, s0 = (p >> 7) * 8;
            float v[8];
#pragma unroll
            for (int e = 0; e < 8; ++e) v[e] = bf2f(rb[it][e]) * rstd[s0 + e] * rgn[it];
            u32x4 o; o.x = pk2(v[0], v[1]); o.y = pk2(v[2], v[3]); o.z = pk2(v[4], v[5]); o.w = pk2(v[6], v[7]);
            *(LAS u32x4*)(Bs + c * 136 + s0) = o; }
        __syncthreads();
        if (g + 1 < 4) SG_PREFETCH(g + 1);
        f32x4 acc[2][4]; mm128(As, Bs, acc, wr, wc, fr, fq);
        { unsigned short uu[2][4][4]; float bias[2][4];
#pragma unroll
          for (int mt = 0; mt < 2; ++mt)
#pragma unroll
            for (int i = 0; i < 4; ++i) { const int row = 32 * wr + 16 * mt + 4 * fq + i; bias[mt][i] = a.sg_b[(l * 4 + g) * 128 + row];
#pragma unroll
                for (int nt = 0; nt < 4; ++nt) uu[mt][i][nt] = Z[(size_t)(r0 + row) * NZ + ZU + g * 128 + 64 * wc + 16 * nt + fr]; }
#pragma unroll
          for (int mt = 0; mt < 2; ++mt)
#pragma unroll
            for (int i = 0; i < 4; ++i) { const int row = 32 * wr + 16 * mt + 4 * fq + i;
#pragma unroll
                for (int nt = 0; nt < 4; ++nt) { const int col = g * 128 + 64 * wc + 16 * nt + fr;
                    O[(size_t)(r0 + row) * 512 + col] = (bf16)(pk2(bf2f(uu[mt][i][nt]) * (acc[mt][nt][i] + bias[mt][i]), 0.f) & 0xffffu); } } }
        __syncthreads();
    }
#undef SG_PREFETCH
}
__device__ __forceinline__ void pool_item(const Args& a, LAS unsigned char* lds, int l, int ci) {
    const int tid = TIDX, lane = tid & 63, w = tid >> 6, fr = lane & 15, fq = lane >> 4, wr = w >> 1, wc = w & 1;
    const int r0 = ci * 128;
    const int T = r0 < MP ? 256 : 1024, base = r0 < MP ? (r0 & ~255) : MP + ((r0 - MP) & ~1023), t0 = r0 - base;
    const bf16* Z = (const bf16*)(a.ws + WS_Z);
    bf16* O = (bf16*)(a.ws + WS_O3) + (size_t)2 * M * 512;
    LAS bf16* As = (LAS bf16*)lds; LAS bf16* Bs = (LAS bf16*)(lds + 34816); LAS bf16* Ts = (LAS bf16*)(lds + 69632);
    const int c = tid & 127, seg = tid >> 7;
    for (int g = 0; g < 4; ++g) {
        const int hw = 1 << g;
        stage_f32_tile_T(a.pool_w + ((size_t)l * 4 + g) * 16384, Bs);
#pragma unroll
        for (int it = 0; it < 5; ++it) { const int ch = tid + 512 * it;
            if (ch < 2304) { const int rr = ch >> 4, c8 = (ch & 15) * 8, tau = t0 - 8 + rr;
                u32x4 v = (u32x4){0u, 0u, 0u, 0u};
                if (tau >= 0 && tau < T) v = *(const u32x4*)(Z + (size_t)(base + tau) * NZ + ZP + g * 128 + c8);
                *(LAS u32x4*)(Ts + rr * 136 + c8) = v; } }
        __syncthreads();
        {
            const int ts = t0 + 32 * seg;
            const LAS bf16* tp = Ts + (32 * seg + 8) * 136 + c;
            float sum = 0.f;
            for (int dd = -hw; dd < hw; ++dd) sum += bf2f(tp[dd * 136]);
#pragma unroll 8
            for (int tt = 0; tt < 32; ++tt) { const int t = ts + tt;
                const int lo = t - hw < 0 ? 0 : t - hw, hi = t + hw > T ? T : t + hw;
                const float cur = bf2f(tp[tt * 136]);
                As[(32 * seg + tt) * 136 + c] = (bf16)(pk2(sum * frcp((float)(hi - lo)) - cur, 0.f) & 0xffffu);
                sum += bf2f(tp[(tt + hw) * 136]) - bf2f(tp[(tt - hw) * 136]); }
        }
        __syncthreads();
        f32x4 acc[2][4]; mm128(As, Bs, acc, wr, wc, fr, fq);
#pragma unroll
        for (int nt = 0; nt < 4; ++nt) { const int col = g * 128 + 64 * wc + 16 * nt + fr; const float sc = a.pool_scale[l * 512 + col];
#pragma unroll
            for (int mt = 0; mt < 2; ++mt)
#pragma unroll
                for (int i = 0; i < 4; ++i) { const int row = 32 * wr + 16 * mt + 4 * fq + i; O[(size_t)(r0 + row) * 512 + col] = (bf16)(pk2(acc[mt][nt][i] * sc, 0.f) & 0xffffu); } }
        __syncthreads();
    }
}
__device__ __forceinline__ void phase_mixers(const Args& a, LAS unsigned char* lds, int l) {
    for (int it = blockIdx.x; it < 480; it += (int)gridDim.x) {
        if (it < 256) { for (int rp = 0; rp <= ((REPMASK >> 10) & 1); ++rp) scan_item(a, lds, l, it >> 3, (it >> 1) & 3, it & 1, 0); }
        else if (it < 320) { const int p = it - 256; for (int rp = 0; rp <= ((REPMASK >> 10) & 1); ++rp) scan_item(a, lds, l, 32 + (p >> 5), (p >> 3) & 3, (p >> 2) & 1, p & 3); }
        else if (it < 400) { for (int rp = 0; rp <= ((REPMASK >> 11) & 1); ++rp) sg_item(a, lds, l, it - 320); }
        else { for (int rp = 0; rp <= ((REPMASK >> 12) & 1); ++rp) pool_item(a, lds, l, it - 400); }
    }
    for (int rp = 0; rp < ((REPMASK >> 13) & 1); ++rp) convert_set(a, lds, l, l == 0 ? 0x7e : 0x40, (int)blockIdx.x * 8 + (TIDX >> 6), (int)gridDim.x * 8);
    if (l == 0) convert_set(a, lds, 0, 0x1e, (int)blockIdx.x * 8 + (TIDX >> 6), (int)gridDim.x * 8);
}
__device__ __forceinline__ void phase_combine(const Args& a, int l, int bidx, int nblk) {
    const int lane = TIDX & 63, wave = TIDX >> 6;
    const int gw = bidx * 8 + wave, NGW = nblk * 8;
    const bf16* Z = (const bf16*)(a.ws + WS_Z); const bf16* OF = (const bf16*)(a.ws + WS_H); const bf16* OB = OF + (size_t)M * 512;
    bf16* O = (bf16*)(a.ws + WS_O3);
    const int c8 = 8 * lane;
    const f32x4 g0 = *(const f32x4*)(a.hg_norm + l * 128 + (c8 & 127)), g1 = *(const f32x4*)(a.hg_norm + l * 128 + (c8 & 127) + 4);
    for (int row = gw; row < MP; row += NGW) {
        const u32x4 f = *(const u32x4*)(OF + (size_t)row * 512 + c8), bb = *(const u32x4*)(OB + (size_t)row * 512 + c8), zg = *(const u32x4*)(Z + (size_t)row * NZ + ZG + c8);
        float v[8], ss = 0.f;
#pragma unroll
        for (int e = 0; e < 4; ++e) { v[2 * e] = bflo(f[e]) + bflo(bb[e]); v[2 * e + 1] = bfhi(f[e]) + bfhi(bb[e]); ss += v[2 * e] * v[2 * e] + v[2 * e + 1] * v[2 * e + 1]; }
        ss += __shfl_xor(ss, 1); ss += __shfl_xor(ss, 2); ss += __shfl_xor(ss, 4); ss += __shfl_xor(ss, 8);
        const float r = rsqrtf(ss * (1.f / 128.f) + EPS);
        u32x4 o;
        o.x = pk2(v[0] * r * g0[0] * bflo(zg.x), v[1] * r * g0[1] * bfhi(zg.x));
        o.y = pk2(v[2] * r * g0[2] * bflo(zg.y), v[3] * r * g0[3] * bfhi(zg.y));
        o.z = pk2(v[4] * r * g1[0] * bflo(zg.z), v[5] * r * g1[1] * bfhi(zg.z));
        o.w = pk2(v[6] * r * g1[2] * bflo(zg.w), v[7] * r * g1[3] * bfhi(zg.w));
        *(u32x4*)(O + (size_t)row * 512 + c8) = o;
    }
}
__device__ __forceinline__ void sample_combine_item(const Args& a, LAS unsigned char* lds, int l, int sq, int tseg, int h, int hf0) {
    const int tid = TIDX, lane = tid & 63, w = tid >> 6, fr = lane & 15, fq = lane >> 4, wr = w >> 1, wc = w & 1;
    LAS bf16* As = (LAS bf16*)lds; LAS bf16* Bs = (LAS bf16*)(lds + 34816); LAS float* Ct = (LAS float*)lds;
    const bf16* Z = (const bf16*)(a.ws + WS_Z); const bf16* OF = (const bf16*)(a.ws + WS_H); const bf16* OB = OF + (size_t)M * 512;
    bf16* O = (bf16*)(a.ws + WS_O3);
    const float* SL = (const float*)(a.ws + WS_SL); const float* AS = (const float*)(a.ws + WS_AS);
    const int hf = hf0;
    f32x4 acc[2][4];
#pragma unroll
    for (int mt = 0; mt < 2; ++mt)
#pragma unroll
        for (int nt = 0; nt < 4; ++nt) acc[mt][nt] = (f32x4){0.f, 0.f, 0.f, 0.f};
    for (int d = 0; d < 2; ++d) {
        const int g = d == 0 ? tseg : 3 - tseg;
        if (g == 0) continue;
        const int ib = ((sq * 4 + h) * 2 + d) * 4;
#pragma unroll
        for (int it = 0; it < 4; ++it) { const int p = tid + 512 * it, v = p & 127, k0 = (p >> 7) * 8;
            float E[8];
#pragma unroll
            for (int e = 0; e < 8; ++e) E[e] = SL[(size_t)ib * 16384 + (k0 + e) * 128 + v];
            for (int gg = 1; gg < g; ++gg) {
#pragma unroll
                for (int e = 0; e < 8; ++e) E[e] = E[e] * AS[(ib + gg) * 128 + k0 + e] + SL[(size_t)(ib + gg) * 16384 + (k0 + e) * 128 + v]; }
            u32x4 o; o.x = pk2(E[0], E[1]); o.y = pk2(E[2], E[3]); o.z = pk2(E[4], E[5]); o.w = pk2(E[6], E[7]);
            *(LAS u32x4*)(Bs + v * 136 + k0) = o; }
        const bf16* QC = (const bf16*)(a.ws + WS_QC) + (size_t)(((sq * 4 + h) * 2 + d) * 1024 + 256 * tseg) * 128;
        {
#pragma unroll
            for (int it = 0; it < 4; ++it) { const int ch = tid + 512 * it, r = ch >> 4, c8 = (ch & 15) * 8;
                *(LAS u32x4*)(As + r * 136 + c8) = *(const u32x4*)(QC + (size_t)(128 * hf + r) * 128 + c8); }
            __syncthreads();
            mm128(As, Bs, acc, wr, wc, fr, fq, false);
            __syncthreads();
        }
    }
    const float gn0 = a.hg_norm[l * 128 + 2 * lane], gn1 = a.hg_norm[l * 128 + 2 * lane + 1];
    {
#pragma unroll
        for (int mt = 0; mt < 2; ++mt)
#pragma unroll
            for (int nt = 0; nt < 4; ++nt)
#pragma unroll
                for (int i = 0; i < 4; ++i) Ct[(32 * wr + 16 * mt + 4 * fq + i) * 132 + 64 * wc + 16 * nt + fr] = acc[mt][nt][i];
        __syncthreads();
        { unsigned pf_[16], pb_[16], zg[16];
          const int grow0 = MP + sq * 1024 + 256 * tseg + 128 * hf + 16 * w;
#pragma unroll
          for (int rr = 0; rr < 16; ++rr) { const size_t go = (size_t)(grow0 + rr) * 512 + h * 128 + 2 * lane;
              pf_[rr] = *(const unsigned*)(OF + go); pb_[rr] = *(const unsigned*)(OB + go); zg[rr] = *(const unsigned*)(Z + (size_t)(grow0 + rr) * NZ + ZG + h * 128 + 2 * lane); }
#pragma unroll
          for (int rr = 0; rr < 16; ++rr) { const int r = 16 * w + rr; const size_t go = (size_t)(grow0 + rr) * 512 + h * 128 + 2 * lane;
              const float v0 = Ct[r * 132 + 2 * lane] + bflo(pf_[rr]) + bflo(pb_[rr]), v1 = Ct[r * 132 + 2 * lane + 1] + bfhi(pf_[rr]) + bfhi(pb_[rr]);
              const float rs = rsqrtf(wave_sum(v0 * v0 + v1 * v1) * (1.f / 128.f) + EPS);
              *(unsigned*)(O + go) = pk2(v0 * rs * gn0 * bflo(zg[rr]), v1 * rs * gn1 * bfhi(zg[rr])); } }
        __syncthreads();
    }
}
__device__ __forceinline__ void phase_conv(const Args& a, int l) {
    const bf16* HF = (const bf16*)(a.ws + WS_Z); bf16* ACT = (bf16*)(a.ws + WS_O3);
    const float* cw = a.conv_w + (size_t)l * 3 * NUP; const float* cb = a.conv_b + (size_t)l * NUP;
    const int total = (M / 8) * 352;
    for (int idx = blockIdx.x * 512 + TIDX; idx < total; idx += (int)gridDim.x * 512) {
        const int run = idx / 352, j0 = (idx - run * 352) * 8, row0 = run * 8;
        const int t0 = row0 < MP ? (row0 & 255) : ((row0 - MP) & 1023), T = row0 < MP ? 256 : 1024;
        float r[2][8][8];
#pragma unroll
        for (int hf = 0; hf < 2; ++hf) { const int col = hf * DFF + j0; const bf16* hp0 = HF + (size_t)row0 * NUP + col;
            u32x4 h[10];
#pragma unroll
            for (int q = 0; q < 10; ++q) { const int t = t0 - 1 + q; h[q] = (t >= 0 && t < T) ? *(const u32x4*)(hp0 + (ptrdiff_t)(q - 1) * NUP) : (u32x4){0u, 0u, 0u, 0u}; }
            const f32x4 wa0 = *(const f32x4*)(cw + col), wa1 = *(const f32x4*)(cw + col + 4), wb0 = *(const f32x4*)(cw + NUP + col), wb1 = *(const f32x4*)(cw + NUP + col + 4);
            const f32x4 wc0 = *(const f32x4*)(cw + 2 * NUP + col), wc1 = *(const f32x4*)(cw + 2 * NUP + col + 4), bi0 = *(const f32x4*)(cb + col), bi1 = *(const f32x4*)(cb + col + 4);
#pragma unroll
            for (int e = 0; e < 4; ++e) {
                const float w0l = e < 2 ? wa0[2 * e] : wa1[2 * e - 4], w0h = e < 2 ? wa0[2 * e + 1] : wa1[2 * e - 3];
                const float w1l = e < 2 ? wb0[2 * e] : wb1[2 * e - 4], w1h = e < 2 ? wb0[2 * e + 1] : wb1[2 * e - 3];
                const float w2l = e < 2 ? wc0[2 * e] : wc1[2 * e - 4], w2h = e < 2 ? wc0[2 * e + 1] : wc1[2 * e - 3];
                const float bl = e < 2 ? bi0[2 * e] : bi1[2 * e - 4], bh = e < 2 ? bi0[2 * e + 1] : bi1[2 * e - 3];
#pragma unroll
                for (int q = 0; q < 8; ++q) {
                    r[hf][q][2 * e] = w0l * bflo(h[q][e]) + w1l * bflo(h[q + 1][e]) + w2l * bflo(h[q + 2][e]) + bl;
                    r[hf][q][2 * e + 1] = w0h * bfhi(h[q][e]) + w1h * bfhi(h[q + 1][e]) + w2h * bfhi(h[q + 2][e]) + bh; } } }
#pragma unroll
        for (int q = 0; q < 8; ++q) { u32x4 o;
            o.x = pk2(silu_f(r[0][q][0]) * r[1][q][0], silu_f(r[0][q][1]) * r[1][q][1]); o.y = pk2(silu_f(r[0][q][2]) * r[1][q][2], silu_f(r[0][q][3]) * r[1][q][3]);
            o.z = pk2(silu_f(r[0][q][4]) * r[1][q][4], silu_f(r[0][q][5]) * r[1][q][5]); o.w = pk2(silu_f(r[0][q][6]) * r[1][q][6], silu_f(r[0][q][7]) * r[1][q][7]);
            *(u32x4*)(ACT + (size_t)(row0 + q) * DFF + j0) = o; }
    }
}

#define XB_TMO      128
#define XB_XCNT(j)  (256  + 64 * (j))
#define XB_XSUB(j)  (1280 + 64 * (j))
#define XB_XGEN(j)  (2304 + 64 * (j))
#define XB_TOP      3328
#define XB_TOPGEN   3392
#define XCD_BAR_WORDS 3456
#define XB_SPIN_CAP (1u << 18)

__device__ __forceinline__ unsigned xb_ld(unsigned* p)              { return __hip_atomic_load(p, __ATOMIC_RELAXED, __HIP_MEMORY_SCOPE_AGENT); }
__device__ __forceinline__ unsigned xb_add(unsigned* p, unsigned v) { return __hip_atomic_fetch_add(p, v, __ATOMIC_RELAXED, __HIP_MEMORY_SCOPE_AGENT); }
__device__ __forceinline__ unsigned xb_xcc_id() { return (unsigned)__builtin_amdgcn_s_getreg((3 << 11) | 20) & 0xFu; }
#define XB_SPIN(cond, bar) do { unsigned _sp = 0; while (cond) { __builtin_amdgcn_s_sleep(1); \
    if ((++_sp & 255u) == 0u) { if (xb_ld(&(bar)[XB_TMO])) break; if (_sp > XB_SPIN_CAP) { atomicAdd(&(bar)[XB_TMO], 1u); break; } } } } while (0)

struct XcdBarrier {
    unsigned* bar; unsigned x;
    volatile LAS unsigned* st;
};

__device__ __forceinline__ XcdBarrier xcd_barrier_post(unsigned* bar, volatile LAS unsigned* st) {
    XcdBarrier b; b.bar = bar; b.x = xb_xcc_id(); b.st = st;
    if (threadIdx.x == 0) (void)xb_add(&bar[XB_XCNT(b.x)], 1u);
    return b;
}
__device__ __forceinline__ void xcd_barrier_complete(unsigned* bar, unsigned x, unsigned& nloc, unsigned& nx) {
    const unsigned G = gridDim.x * gridDim.y * gridDim.z;
    unsigned sum, cnt, mine, sp = 0u;
    for (;;) {
        sum = 0u; cnt = 0u; mine = 0u;
#pragma unroll
        for (unsigned j = 0; j < 16; ++j) { const unsigned c = xb_ld(&bar[XB_XCNT(j)]); sum += c; cnt += (c > 0u) ? 1u : 0u; mine = (j == x) ? c : mine; }
        if (sum == G) break;
        __builtin_amdgcn_s_sleep(1);
        if ((++sp & 255u) == 0u) { if (xb_ld(&bar[XB_TMO])) break; if (sp > XB_SPIN_CAP) { atomicAdd(&bar[XB_TMO], 1u); break; } }
    }
    nloc = mine > 0u ? mine : 1u; nx = cnt > 0u ? cnt : 1u;
}

__device__ __forceinline__ void xcd_barrier(const XcdBarrier& b) {
    asm volatile("s_waitcnt vmcnt(0)" ::: "memory");
    __syncthreads();
    if (threadIdx.x == 0) {
        unsigned* bar = b.bar;
        __builtin_amdgcn_s_waitcnt(0);
        unsigned nloc = b.st[0], nx = b.st[1];
        if (nloc == 0u) { xcd_barrier_complete(bar, b.x, nloc, nx); b.st[0] = nloc; b.st[1] = nx; }
        const unsigned old = xb_add(&bar[XB_XSUB(b.x)], 1u);
        const unsigned gen = old / nloc;
        if (old + 1u == (gen + 1u) * nloc) {
            __builtin_amdgcn_fence(__ATOMIC_RELEASE, "agent");
            asm volatile("s_waitcnt vmcnt(0)" ::: "memory");
            const unsigned og = xb_add(&bar[XB_TOP], 1u);
            const unsigned tg = og / nx;
            if (og + 1u == (tg + 1u) * nx) xb_add(&bar[XB_TOPGEN], 1u);
            else XB_SPIN(xb_ld(&bar[XB_TOPGEN]) == tg, bar);
            __builtin_amdgcn_fence(__ATOMIC_ACQUIRE, "agent");
            xb_add(&bar[XB_XGEN(b.x)], 1u);
            asm volatile("s_waitcnt vmcnt(0)" ::: "memory");
        } else {
            XB_SPIN(xb_ld(&bar[XB_XGEN(b.x)]) == gen, bar);
            __builtin_amdgcn_fence(__ATOMIC_ACQUIRE, "agent");
            asm volatile("s_waitcnt vmcnt(0)" ::: "memory");
        }
    }
    __syncthreads();
}

__global__ void __launch_bounds__(512, 2) fwd_kernel(Args a) {
    extern __shared__ __attribute__((aligned(16))) unsigned char lds_raw[];
    LAS unsigned char* lds = (LAS unsigned char*)lds_raw;
    cg::grid_group grid = cg::this_grid();
    unsigned char* ws = a.ws;
    const int G = gridDim.x, bid = blockIdx.x;
    if (threadIdx.x < 4) ((volatile LAS unsigned*)(lds + 131072 + 64))[threadIdx.x] = 0u;
    __syncthreads();
    const XcdBarrier bar = xcd_barrier_post((unsigned*)(a.ws + WS_BAR), (volatile LAS unsigned*)(lds + 131072 + 64));
    for (int ph = a.ph_lo; ph < a.ph_hi; ++ph) {
        if (ph == 0 && PHSEL(100)) { phase_mods(a, lds); convert_set(a, lds, 0, 1, bid * 8 + (TIDX >> 6), G * 8); }
        else if (ph == NPHASE - 1 && PHSEL(101)) { phase_final(a); }
        else {
            const int l = (ph - 1) / 10, sp = (ph - 1) % 10;
            for (int rep = 0; rep <= ((REPMASK >> sp) & 1); ++rep) {
            const float* mods = (const float*)(ws + WS_MOD) + (size_t)l * 3 * NMOD;
            if ((sp == 0 || sp == 6) && PHSEL(0)) { phase_norm(a, l, (sp == 0 ? a.norm_mix : a.norm_ffn) + l * D, sp == 0 ? 0 : 3 * D, sp == 0 && l == 0); }
            else if ((sp == 1 || sp == 7) && PHSEL(1)) {
                const bool up = sp == 7;
                pg8::Gemm g{(const bf16*)(ws + WS_H), (const bf16*)(ws + (up ? WS_WUP : WS_WIN)), M, up ? NUP : NZ, D}; pg8::StaticOrder S; S.init(M, up ? NUP : NZ, G, bid);
                pg8::EpiZ E{(bf16*)(ws + WS_Z), up ? NUP : NZ, up ? 1 : 0}; pg8::gemm_phase<pg8::EpiZ, pg8::StaticOrder, true, true>(lds, g, S, E); }
            else if (sp == 2 && PHSEL(2)) { phase_mixers(a, lds, l); }
            else if (sp == 3 && PHSEL(3)) { if (bid < 64) sample_combine_item(a, lds, l, bid >> 5, (bid >> 3) & 3, (bid >> 1) & 3, bid & 1); else phase_combine(a, l, bid - 64, G - 64); }
            else if (sp == 4 && PHSEL(4)) { pg8::Gemm g{(const bf16*)(ws + WS_O3), (const bf16*)(ws + WS_WBR), M, D, 512}; pg8::TileOrder S{bid, 3};
                pg8::EpiBranch E{(const bf16*)(ws + WS_Z), (bf16*)(ws + WS_H)}; pg8::gemm_phase<pg8::EpiBranch, pg8::TileOrder, true, true>(lds, g, S, E);
                if ((bid >> 3) >= 20) convert_set(a, lds, l, l == 0 ? 0x60 : 0x40, ((bid >> 3) - 20) * 64 + (bid & 7) * 8 + (TIDX >> 6), 12 * 64); }
            else if ((sp == 5 || sp == 9) && PHSEL(5)) {
                const bool dn = sp == 9;
                pg8::Gemm g{(const bf16*)(ws + (dn ? WS_O3 : WS_H)), (const bf16*)(ws + (dn ? WS_WDN : WS_WOUT)), M, D, dn ? DFF : D}; pg8::TileOrder S{bid, 1};
                pg8::EpiResid E{a.out, mods + (dn ? 5 * D : 2 * D)}; pg8::gemm_phase<pg8::EpiResid, pg8::TileOrder, true, true>(lds, g, S, E);
                if (dn && l == 0 && (bid >> 3) >= 20) convert_set(a, lds, 1, 0x3f, ((bid >> 3) - 20) * 64 + (bid & 7) * 8 + (TIDX >> 6), 12 * 64); }
            else if (sp == 8 && PHSEL(8)) { phase_conv(a, l); }
            }
        }
        if (ph + 1 < a.ph_hi) { if (a.ph_hi > 1000) grid.sync(); else xcd_barrier(bar); }
    }
}

extern "C" void kernel_launch(void* const* d_in, const int* in_sizes, int n_in, void* d_out, int out_size, void* d_ws, size_t ws_size, hipStream_t stream) {
    static int grid = 0;
    if (grid == 0) {
        if (n_in != 26 || ws_size < WS_END) { fprintf(stderr, "kernel_launch: expected 26 inputs and >= %zu bytes of workspace (got %d, %zu)\n", (size_t)WS_END, n_in, ws_size); grid = -1; return; }
        int dev = 0, cus = 0, per_cu = 0;
        hipGetDevice(&dev); hipDeviceGetAttribute(&cus, hipDeviceAttributeMultiprocessorCount, dev);
        if (hipFuncSetAttribute((const void*)fwd_kernel, hipFuncAttributeMaxDynamicSharedMemorySize, LDS_BYTES) != hipSuccess) { fprintf(stderr, "kernel_launch: hipFuncSetAttribute failed\n"); grid = -1; return; }
        hipOccupancyMaxActiveBlocksPerMultiprocessor(&per_cu, (const void*)fwd_kernel, 512, LDS_BYTES);
        if (per_cu < 1) { fprintf(stderr, "kernel_launch: occupancy query says %d blocks per CU\n", per_cu); per_cu = 1; }
        (void)hipGetLastError();
        grid = cus;
    }
    if (grid < 0) return;
    if (hipMemsetAsync((char*)d_ws + WS_BAR, 0, 16384, stream) != hipSuccess) { fprintf(stderr, "kernel_launch: memset failed\n"); return; }
    Args a{};
    const float** p = (const float**)&a;
    for (int i = 0; i < 26; ++i) p[i] = (const float*)d_in[i];
    a.out = (float*)d_out; a.ws = (unsigned char*)d_ws;
#if MK_SPLIT
    for (int ph = 0; ph < NPHASE; ++ph) { a.ph_lo = ph; a.ph_hi = ph + 1; hipLaunchKernelGGL(fwd_kernel, dim3(grid), dim3(512), LDS_BYTES, stream, a); }
#else
    a.ph_lo = 0; a.ph_hi = NPHASE;
    void* args[] = {&a};
    hipError_t e = hipLaunchCooperativeKernel((const void*)fwd_kernel, dim3(grid), dim3(512), args, LDS_BYTES, stream);
    if (e != hipSuccess) fprintf(stderr, "cooperative launch failed: %s (grid %d)\n", hipGetErrorString(e), grid);
#endif
}
```

```cpp
#include <hip/hip_runtime.h>
#include <hip/hip_cooperative_groups.h>
#include <cstdio>
#include <cstdint>
namespace cg = cooperative_groups;

#ifndef MK_SPLIT
#define MK_SPLIT 0
#endif

#ifndef REPMASK
#define REPMASK 0
#endif
#ifndef PHSEL
#define PHSEL(x) true
#endif
#define LAS __attribute__((address_space(3)))
__device__ __forceinline__ int opaque_tid() { int t = (int)threadIdx.x; asm volatile("" : "+v"(t)); return t; }
#define TIDX opaque_tid()
typedef unsigned short bf16;
typedef float f32x4 __attribute__((ext_vector_type(4)));
typedef short bf16x8 __attribute__((ext_vector_type(8)));
typedef short s16x4 __attribute__((ext_vector_type(4)));
typedef unsigned u32x4 __attribute__((ext_vector_type(4)));
typedef unsigned u32x2 __attribute__((ext_vector_type(2)));

__device__ __forceinline__ float bf2f(unsigned v) { return __uint_as_float(v << 16); }
__device__ __forceinline__ float bflo(unsigned w) { return __uint_as_float(w << 16); }
__device__ __forceinline__ float bfhi(unsigned w) { return __uint_as_float(w & 0xffff0000u); }
__device__ __forceinline__ unsigned f2bf(float f) { unsigned u = __float_as_uint(f); return (u + 0x7fffu + ((u >> 16) & 1u)) >> 16; }
typedef float f32x2_t __attribute__((ext_vector_type(2))); typedef __bf16 bf16x2_t __attribute__((ext_vector_type(2)));
__device__ __forceinline__ unsigned pk2(float lo, float hi) { f32x2_t v = {lo, hi}; bf16x2_t b = __builtin_convertvector(v, bf16x2_t); return __builtin_bit_cast(unsigned, b); }
__device__ __forceinline__ float frcp(float x) { return __builtin_amdgcn_rcpf(x); }
__device__ __forceinline__ float sigm(float x) { return frcp(1.f + __expf(-x)); }
__device__ __forceinline__ float silu_f(float x) { return x * sigm(x); }
__device__ __forceinline__ float gelu_f(float x) { return x * sigm(1.5957691216057308f * (x + 0.044715f * x * x * x)); }
__device__ __forceinline__ float wave_sum(float v) {
#pragma unroll
    for (int o = 1; o < 64; o <<= 1) v += __shfl_xor(v, o);
    return v;
}

namespace pg8 {
#define PG8_LAS __attribute__((address_space(3)))
typedef unsigned short bf16_t;
constexpr int BM = 256, BK = 64, HALF = 128, HTB = HALF * BK * 2, STAGE_BYTES = 8 * HTB, NXCD = 8, WGM = 8;
__host__ __device__ __forceinline__ int lds_byte(int r, int c) { const int st = (r >> 4) * 2 + (c >> 5), rr = r & 15, cc = c & 31, ob = rr * 64 + cc * 2; return st * 1024 + (ob ^ (((ob >> 9) & 1) << 5)); }
__host__ __device__ __forceinline__ void stage_rc(int b, int& R, int& C) { const int st = b / 1024, sb = b % 1024, swz = sb ^ (((sb >> 9) & 1) << 5); R = (st >> 1) * 16 + swz / 64; C = (st & 1) * 32 + (swz % 64) / 2; }
__host__ __device__ __forceinline__ int perm32(int rho) { const int n = rho >> 4, i = rho & 15; return 8 * (i >> 2) + 4 * n + (i & 3); }
struct Unit { int pm, pn; };
struct Gemm { const bf16_t* A; const bf16_t* Bt; int M, N, K; };
struct StaticOrder {
    int nM, nN, nwg, G, c;
    __host__ __device__ void init(int M, int N, int G_, int c_) { nM = M / BM; nN = N / BM; nwg = nM * nN; G = G_; c = c_; }
    __host__ __device__ bool next(int i, Unit& u) const {
        const long L = (long)i * G + c; if (L >= nwg) return false;
        int wgid = (int)L; { const int q = nwg / NXCD, r = nwg % NXCD, xcd = wgid % NXCD, off = wgid / NXCD; wgid = (xcd < r ? xcd * (q + 1) : r * (q + 1) + (xcd - r) * q) + off; }
        const int nig = WGM * nN, gid = wgid / nig, fm = gid * WGM, gsz = (nM - fm) < WGM ? (nM - fm) : WGM;
        u.pm = fm + ((wgid % nig) % gsz); u.pn = (wgid % nig) / gsz; return true;
    }
    __device__ __forceinline__ void a_ready(const Unit&) const {}
    __device__ __forceinline__ void done(const Unit&) const {}
};
struct TileOrder {
    int c, nch;
    __device__ bool next(int i, Unit& u) const {
        const int xcd = c & 7, slot = c >> 3; if (slot >= 20 || i >= nch) return false;
        const int L = xcd * 20 + slot; u.pm = i * 40 + (L >> 2); u.pn = i * 4 + (L & 3); return true;
    }
    __device__ __forceinline__ void a_ready(const Unit&) const {}
    __device__ __forceinline__ void done(const Unit&) const {}
};
__device__ __forceinline__ unsigned cvt_pk_bf16(float lo, float hi) { return pk2(lo, hi); }

struct EpiStore {
    static constexpr bool PERM = true, AFTER_DRAIN = false;
    bf16_t* O; int ldc;
    __device__ __forceinline__ bool zero_after(const Unit&) const { return true; }
    __device__ __forceinline__ void operator()(f32x4 (&acc)[2][2][4][2], const Unit& u, int wr, int wc, int fr, int fq) const {
        const int row0 = u.pm * BM + wr * 64 + fr, col0 = u.pn * BM + wc * 32 + 8 * fq;
#pragma unroll
        for (int ai = 0; ai < 2; ++ai)
#pragma unroll
            for (int m = 0; m < 4; ++m) { bf16_t* rowp = O + (size_t)(row0 + ai * HALF + m * 16) * ldc + col0;
#pragma unroll
                for (int bj = 0; bj < 2; ++bj) { const f32x4 v0 = acc[ai][bj][m][0], v1 = acc[ai][bj][m][1];
                    u32x4 w; w.x = cvt_pk_bf16(v0[0], v0[1]); w.y = cvt_pk_bf16(v0[2], v0[3]); w.z = cvt_pk_bf16(v1[0], v1[1]); w.w = cvt_pk_bf16(v1[2], v1[3]);
                    *(u32x4*)(rowp + bj * HALF) = w; } }
    }
};
struct EpiZ {
    static constexpr bool PERM = true, AFTER_DRAIN = false;
    bf16_t* O; int ldc; int plain;
    __device__ __forceinline__ bool zero_after(const Unit&) const { return true; }
    __device__ __forceinline__ void operator()(f32x4 (&acc)[2][2][4][2], const Unit& u, int wr, int wc, int fr, int fq) const {
        const int row0 = u.pm * BM + wr * 64 + fr, col0 = u.pn * BM + wc * 32 + 8 * fq;
        const int pn = u.pn;
        const int mode = plain ? 0 : pn < 2 ? 1 : (pn < 8 ? 0 : (pn < 10 ? 2 : (pn < 14 ? 3 : (pn < 16 ? 0 : 4))));
#pragma unroll
        for (int ai = 0; ai < 2; ++ai)
#pragma unroll
            for (int m = 0; m < 4; ++m) { bf16_t* rowp = O + (size_t)(row0 + ai * HALF + m * 16) * ldc + col0;
#pragma unroll
                for (int bj = 0; bj < 2; ++bj) { float v[8];
#pragma unroll
                    for (int e = 0; e < 4; ++e) { v[e] = acc[ai][bj][m][0][e]; v[4 + e] = acc[ai][bj][m][1][e]; }
                    if (mode == 1) {
#pragma unroll
                        for (int e = 0; e < 8; ++e) v[e] = v[e] * sigm(v[e]) * 0.08838834764831845f;
                    } else if (mode == 2) {
#pragma unroll
                        for (int e = 0; e < 8; ++e) v[e] = v[e] * sigm(v[e]);
                    } else if (mode == 3) {
#pragma unroll
                        for (int e = 0; e < 8; ++e) v[e] = gelu_f(v[e]);
                    } else if (mode == 4) {
#pragma unroll
                        for (int e = 0; e < 8; ++e) v[e] = sigm(v[e]);
                    }
                    u32x4 w; w.x = cvt_pk_bf16(v[0], v[1]); w.y = cvt_pk_bf16(v[2], v[3]); w.z = cvt_pk_bf16(v[4], v[5]); w.w = cvt_pk_bf16(v[6], v[7]);
                    *(u32x4*)(rowp + bj * HALF) = w; } }
    }
};
struct EpiResid {
    static constexpr bool PERM = true, AFTER_DRAIN = false;
    float* X; const float* gate;
    __device__ __forceinline__ bool zero_after(const Unit&) const { return true; }
    __device__ __forceinline__ void operator()(f32x4 (&acc)[2][2][4][2], const Unit& u, int wr, int wc, int fr, int fq) const {
        const int modrow = u.pm < 32 ? 0 : 1 + ((u.pm - 32) >> 2);
        const int row0 = u.pm * BM + wr * 64 + fr, col0 = u.pn * BM + wc * 32 + 8 * fq;
        const float* g = gate + modrow * 6144 + col0;
        f32x4 gv[2][2];
#pragma unroll
        for (int bj = 0; bj < 2; ++bj) { gv[bj][0] = *(const f32x4*)(g + bj * HALF); gv[bj][1] = *(const f32x4*)(g + bj * HALF + 4); }
#pragma unroll
        for (int ai = 0; ai < 2; ++ai) {
            f32x4 xv[4][2][2];
#pragma unroll
            for (int m = 0; m < 4; ++m) { const float* rowp = X + (size_t)(row0 + ai * HALF + m * 16) * 1024 + col0;
#pragma unroll
                for (int bj = 0; bj < 2; ++bj) { xv[m][bj][0] = *(const f32x4*)(rowp + bj * HALF); xv[m][bj][1] = *(const f32x4*)(rowp + bj * HALF + 4); } }
#pragma unroll
            for (int m = 0; m < 4; ++m) { float* rowp = X + (size_t)(row0 + ai * HALF + m * 16) * 1024 + col0;
#pragma unroll
                for (int bj = 0; bj < 2; ++bj) {
                    *(f32x4*)(rowp + bj * HALF) = xv[m][bj][0] + gv[bj][0] * acc[ai][bj][m][0]; *(f32x4*)(rowp + bj * HALF + 4) = xv[m][bj][1] + gv[bj][1] * acc[ai][bj][m][1]; } }
            asm volatile("" ::: "memory"); }
    }
};
struct EpiBranch {
    static constexpr bool PERM = true, AFTER_DRAIN = false;
    const bf16_t* Z; bf16_t* O;
    __device__ __forceinline__ bool zero_after(const Unit& u) const { return u.pm >= 80; }
    __device__ __forceinline__ void operator()(f32x4 (&acc)[2][2][4][2], const Unit& u, int wr, int wc, int fr, int fq) const {
        const int br = u.pm / 40, pm = u.pm - br * 40, pn = u.pn - br * 4;
        const int row0 = pm * BM + wr * 64 + fr, col0 = pn * BM + wc * 32 + 8 * fq;
#pragma unroll
        for (int ai = 0; ai < 2; ++ai) {
            u32x4 gcv[4][2], gnv[4][2];
#pragma unroll
            for (int m = 0; m < 4; ++m)
#pragma unroll
                for (int bj = 0; bj < 2; ++bj) { const bf16_t* zq_ = Z + (size_t)(row0 + ai * HALF + m * 16) * 7168 + 4096 + br * 1024 + col0 + bj * HALF;
                    gcv[m][bj] = *(const u32x4*)zq_; gnv[m][bj] = br < 2 ? *(const u32x4*)(zq_ + 1024) : (u32x4){0u, 0u, 0u, 0u}; }
#pragma unroll
            for (int m = 0; m < 4; ++m) { const int row = row0 + ai * HALF + m * 16;
#pragma unroll
                for (int bj = 0; bj < 2; ++bj) {
                    const bf16_t* zp = Z + (size_t)row * 7168 + 4096 + br * 1024 + col0 + bj * HALF;
                    const u32x4 gc = gcv[m][bj];
                    float f[8];
                    if (br < 2) { const u32x4 gn = gnv[m][bj];
#pragma unroll
                        for (int e = 0; e < 4; ++e) { f[2 * e] = bflo(gc[e]) * frcp(fmaxf(bflo(gn[e]), 1e-20f)); f[2 * e + 1] = bfhi(gc[e]) * frcp(fmaxf(bfhi(gn[e]), 1e-20f)); }
                    } else {
#pragma unroll
                        for (int e = 0; e < 4; ++e) { f[2 * e] = bflo(gc[e]); f[2 * e + 1] = bfhi(gc[e]); }
                    }
                    f32x4 v0 = acc[ai][bj][m][0], v1 = acc[ai][bj][m][1];
                    v0[0] *= f[0]; v0[1] *= f[1]; v0[2] *= f[2]; v0[3] *= f[3]; v1[0] *= f[4]; v1[1] *= f[5]; v1[2] *= f[6]; v1[3] *= f[7];
                    if (br < 2) { acc[ai][bj][m][0] = v0; acc[ai][bj][m][1] = v1; }
                    else { u32x4 w; w.x = cvt_pk_bf16(v0[0], v0[1]); w.y = cvt_pk_bf16(v0[2], v0[3]); w.z = cvt_pk_bf16(v1[0], v1[1]); w.w = cvt_pk_bf16(v1[2], v1[3]);
                        *(u32x4*)(O + (size_t)row * 1024 + col0 + bj * HALF) = w; }
                } } }
    }
};

template <class Epi, class Sched, bool ALIGN_EPI = false, bool SP2 = false>
__device__ __forceinline__ void gemm_phase(PG8_LAS unsigned char* lds, const Gemm g, const Sched& S, const Epi& E) {
    const int tid = TIDX, wid = __builtin_amdgcn_readfirstlane(tid >> 6), lane = tid & 63, wr = wid >> 2, wc = wid & 3, fr = lane & 15, fq = lane >> 4;
    const int K = g.K, nt = K / BK;
    unsigned voffA[2], voffB[2];
#pragma unroll
    for (int i = 0; i < 2; ++i) { int R, C; stage_rc(tid * 16 + i * 8192, R, C); const int Rb = Epi::PERM ? ((R & ~31) + perm32(R & 31)) : R;
        voffA[i] = (unsigned)(R * K + C) * 2u; voffB[i] = (unsigned)(Rb * K + C) * 2u; }
    const size_t kstep = (size_t)(BK * 2);
    const size_t hstep = (size_t)HALF * K * 2;
    const size_t tstep = 2 * hstep;
    const unsigned ldsw = (unsigned)wid * 1024u;
    const int aoff = lds_byte(wr * 64 + fr, fq * 8), boff = lds_byte(wc * 32 + fr, fq * 8);
#define PG8_SA(b, h) (((b) * 2 + (h)) * HTB)
#define PG8_SB(b, h) ((4 + (b) * 2 + (h)) * HTB)
#define PG8_STAGE(bufoff, gbase, voff) do { _Pragma("unroll") for (int _i = 0; _i < 2; ++_i) \
        __builtin_amdgcn_global_load_lds((const unsigned*)((const char*)(gbase) + (voff)[_i]), (PG8_LAS unsigned*)(lds + (bufoff) + ldsw + _i * 8192), 16, 0, 0); } while (0)
#define PG8_LDA(dst, b, h) do { _Pragma("unroll") for (int m = 0; m < 4; ++m) _Pragma("unroll") for (int k = 0; k < 2; ++k) dst[m][k] = *(const PG8_LAS bf16x8*)(lds + PG8_SA(b, h) + aoff + m * 2048 + k * 1024); } while (0)
#define PG8_LDB(dst, b, h) do { _Pragma("unroll") for (int n = 0; n < 2; ++n) _Pragma("unroll") for (int k = 0; k < 2; ++k) dst[n][k] = *(const PG8_LAS bf16x8*)(lds + PG8_SB(b, h) + boff + n * 2048 + k * 1024); } while (0)
#define PG8_MMA(ai, bj, At, Bt) do { __builtin_amdgcn_s_setprio(1); _Pragma("unroll") for (int m = 0; m < 4; ++m) _Pragma("unroll") for (int n = 0; n < 2; ++n) _Pragma("unroll") for (int k = 0; k < 2; ++k) \
        acc[ai][bj][m][n] = __builtin_amdgcn_mfma_f32_16x16x32_bf16(Bt[n][k], At[m][k], acc[ai][bj][m][n], 0, 0, 0); __builtin_amdgcn_s_setprio(0); } while (0)
#define PG8_WAIT_V(n) asm volatile("s_waitcnt vmcnt(" #n ")" ::: "memory")
#define PG8_WAIT_L(n) asm volatile("s_waitcnt lgkmcnt(" #n ")" ::: "memory")
#define PG8_BAR __builtin_amdgcn_s_barrier()
#define PG8_SCHED __builtin_amdgcn_sched_barrier(0)
    Unit cur, nxt; int ui = 0;
    if (!S.next(0, cur)) return;
    f32x4 acc[2][2][4][2];
#pragma unroll
    for (int a = 0; a < 2; ++a)
#pragma unroll
        for (int b = 0; b < 2; ++b)
#pragma unroll
            for (int m = 0; m < 4; ++m)
#pragma unroll
                for (int n = 0; n < 2; ++n) acc[a][b][m][n] = (f32x4){0.f, 0.f, 0.f, 0.f};
    bf16x8 At[4][2], B0[2][2], B1[2][2];
    const char* cA = (const char*)g.A + (size_t)cur.pm * tstep; const char* cB = (const char*)g.Bt + (size_t)cur.pn * tstep;
    S.a_ready(cur);
    if constexpr (SP2) {
        PG8_STAGE(PG8_SB(0, 0), cB, voffB); PG8_STAGE(PG8_SB(0, 1), cB + hstep, voffB); PG8_STAGE(PG8_SA(0, 0), cA, voffA); PG8_STAGE(PG8_SA(0, 1), cA + hstep, voffA);
        if (wr == 1) PG8_BAR;
        PG8_WAIT_V(2); PG8_BAR;
        PG8_STAGE(PG8_SB(1, 0), cB + kstep, voffB); PG8_STAGE(PG8_SA(1, 0), cA + kstep, voffA); PG8_STAGE(PG8_SB(1, 1), cB + hstep + kstep, voffB);
        PG8_WAIT_V(6); PG8_BAR;
    } else {
        PG8_STAGE(PG8_SB(0, 0), cB, voffB); PG8_STAGE(PG8_SA(0, 0), cA, voffA); PG8_STAGE(PG8_SB(0, 1), cB + hstep, voffB); PG8_STAGE(PG8_SA(0, 1), cA + hstep, voffA);
        if (wr == 1) PG8_BAR;
        PG8_WAIT_V(4); PG8_BAR;
        PG8_STAGE(PG8_SB(1, 0), cB + kstep, voffB); PG8_STAGE(PG8_SA(1, 0), cA + kstep, voffA); PG8_STAGE(PG8_SB(1, 1), cB + hstep + kstep, voffB);
        PG8_WAIT_V(6); PG8_BAR;
    }
    for (;;) {
        const bool has_next = S.next(ui + 1, nxt);
        const char* nA = has_next ? (const char*)g.A + (size_t)nxt.pm * tstep : cA; const char* nB = has_next ? (const char*)g.Bt + (size_t)nxt.pn * tstep : cB;
        for (int t = 0; t < nt; t += 2) {
            const bool last = (t == nt - 2);
            const char* a1 = cA + (size_t)(t + 1) * kstep;
            const char* a2 = last ? nA : cA + (size_t)(t + 2) * kstep; const char* b2 = last ? nB : cB + (size_t)(t + 2) * kstep;
            const char* a3 = a2 + kstep; const char* b3 = b2 + kstep;
            if (last && has_next) S.a_ready(nxt);
            if constexpr (SP2) {
            PG8_LDB(B0, 0, 0); PG8_LDB(B1, 0, 1); PG8_SCHED; PG8_LDA(At, 0, 0); PG8_STAGE(PG8_SA(1, 1), a1 + hstep, voffA);
            PG8_WAIT_V(8); PG8_WAIT_L(0); PG8_BAR; PG8_MMA(0, 0, At, B0); PG8_MMA(0, 1, At, B1); PG8_BAR; PG8_SCHED;
            PG8_LDA(At, 0, 1); PG8_STAGE(PG8_SB(0, 0), b2, voffB); PG8_STAGE(PG8_SB(0, 1), b2 + hstep, voffB); PG8_STAGE(PG8_SA(0, 0), a2, voffA);
            PG8_WAIT_V(8); PG8_WAIT_L(0); PG8_BAR; PG8_MMA(1, 0, At, B0); PG8_MMA(1, 1, At, B1); PG8_BAR; PG8_SCHED;
            PG8_LDB(B0, 1, 0); PG8_LDB(B1, 1, 1); PG8_SCHED; PG8_LDA(At, 1, 0); PG8_STAGE(PG8_SA(0, 1), a2 + hstep, voffA);
            PG8_WAIT_V(8); PG8_WAIT_L(0); PG8_BAR; PG8_MMA(0, 0, At, B0); PG8_MMA(0, 1, At, B1); PG8_BAR; PG8_SCHED;
            PG8_LDA(At, 1, 1); PG8_STAGE(PG8_SB(1, 0), b3, voffB); PG8_STAGE(PG8_SB(1, 1), b3 + hstep, voffB); PG8_STAGE(PG8_SA(1, 0), a3, voffA);
            PG8_WAIT_V(8); PG8_WAIT_L(0); PG8_BAR; PG8_MMA(1, 0, At, B0); PG8_MMA(1, 1, At, B1); PG8_BAR; PG8_SCHED;
            } else {
            PG8_LDB(B0, 0, 0); PG8_SCHED; PG8_LDA(At, 0, 0); PG8_STAGE(PG8_SA(1, 1), a1 + hstep, voffA);
            PG8_WAIT_L(8); PG8_BAR; PG8_WAIT_L(0); PG8_MMA(0, 0, At, B0); PG8_BAR; PG8_SCHED;
            PG8_LDB(B1, 0, 1); PG8_STAGE(PG8_SB(0, 0), b2, voffB);
            PG8_BAR; PG8_WAIT_L(0); PG8_MMA(0, 1, At, B1); PG8_BAR;
            PG8_LDA(At, 0, 1); PG8_STAGE(PG8_SA(0, 0), a2, voffA);
            PG8_BAR; PG8_WAIT_L(0); PG8_MMA(1, 0, At, B0); PG8_BAR; PG8_SCHED;
            PG8_STAGE(PG8_SB(0, 1), b2 + hstep, voffB);
            PG8_WAIT_V(6); PG8_BAR; PG8_MMA(1, 1, At, B1); PG8_BAR;
            PG8_LDB(B0, 1, 0); PG8_SCHED; PG8_LDA(At, 1, 0); PG8_STAGE(PG8_SA(0, 1), a2 + hstep, voffA);
            PG8_WAIT_L(8); PG8_BAR; PG8_WAIT_L(0); PG8_MMA(0, 0, At, B0); PG8_BAR; PG8_SCHED;
            PG8_LDB(B1, 1, 1); PG8_STAGE(PG8_SB(1, 0), b3, voffB);
            PG8_BAR; PG8_WAIT_L(0); PG8_MMA(0, 1, At, B1); PG8_BAR;
            PG8_LDA(At, 1, 1); PG8_STAGE(PG8_SA(1, 0), a3, voffA);
            PG8_BAR; PG8_WAIT_L(0); PG8_MMA(1, 0, At, B0); PG8_BAR; PG8_SCHED;
            PG8_STAGE(PG8_SB(1, 1), b3 + hstep, voffB);
            PG8_WAIT_V(6); PG8_BAR; PG8_MMA(1, 1, At, B1); PG8_BAR;
            }
        }
        if constexpr (ALIGN_EPI) { if (wr == 0) PG8_BAR; }
        E(acc, cur, wr, wc, fr, fq);
        if (!has_next) break;
        if (E.zero_after(cur)) {
#pragma unroll
        for (int a = 0; a < 2; ++a)
#pragma unroll
            for (int b = 0; b < 2; ++b)
#pragma unroll
                for (int m = 0; m < 4; ++m)
#pragma unroll
                    for (int n = 0; n < 2; ++n) acc[a][b][m][n] = (f32x4){0.f, 0.f, 0.f, 0.f};
        }
        cur = nxt; cA = nA; cB = nB; ++ui;
        if constexpr (ALIGN_EPI) { if (wr == 1) PG8_BAR; }
    }
    PG8_WAIT_V(0);
    if constexpr (!ALIGN_EPI) { if (wr == 0) PG8_BAR; }
    PG8_BAR;

#undef PG8_SA
#undef PG8_SB
#undef PG8_STAGE
#undef PG8_LDA
#undef PG8_LDB
#undef PG8_MMA
#undef PG8_WAIT_V
#undef PG8_WAIT_L
#undef PG8_BAR
#undef PG8_SCHED
}
}

constexpr int D = 1024, MP = 8192, M = 10240, NZ = 7168, DFF = 2816, NUP = 5632, NMOD = 6144;
constexpr int ZQ = 0, ZFF = 512, ZI = 1536, ZG = 2048, ZU = 2560, ZV = 3072, ZP = 3584;
constexpr float EPS = 1e-6f;
constexpr size_t MiB = 1u << 20;
constexpr size_t WS_BAR = 512 * 1024, WS_MOD = 0, WS_WIN = 1 * MiB, WS_WBR = 15 * MiB, WS_WOUT = 18 * MiB, WS_WUP = 20 * MiB, WS_WDN = 31 * MiB, WS_H = 37 * MiB, WS_Z = 57 * MiB, WS_O3 = 197 * MiB, WS_END = 252 * MiB;
constexpr size_t WS_SL = WS_O3 + 30 * MiB, WS_QC = WS_O3 + 34 * MiB, WS_AS = WS_O3 + 38 * MiB;
constexpr int LDS_BYTES = 147456;
constexpr int NPHASE = 22;

struct Args {
    const float *x_prompt, *x_sample, *c, *state, *c_ctx, *norm_mix, *norm_ffn, *w_ada, *b_ada, *w_in, *lb_logits, *hg_norm, *w_br_hg, *w_br_sg, *w_br_pool, *w_out,
        *sg_norm, *sg_w, *sg_b, *pool_w, *pool_scale, *ffn_up, *conv_w, *conv_b, *ffn_down, *final_norm;
    float* out; unsigned char* ws; int ph_lo, ph_hi;
};

__device__ __forceinline__ void transpose_item(const float* W, int K, int N, bf16* WT, LAS float* scr, int item, int lane) {
    const int nblk = N / 32, kb = item / nblk, nb = item % nblk, k0 = 64 * kb, n0 = 32 * nb;
    float wv[32];
#pragma unroll
    for (int i = 0; i < 32; ++i) wv[i] = W[(size_t)(k0 + 2 * i + (lane >> 5)) * N + n0 + (lane & 31)];
#pragma unroll
    for (int i = 0; i < 32; ++i) scr[(2 * i + (lane >> 5)) * 33 + (lane & 31)] = wv[i];
    asm volatile("s_waitcnt lgkmcnt(0)" ::: "memory");
    const int c = lane & 7;
#pragma unroll
    for (int j = 0; j < 4; ++j) { const int n = (lane >> 3) + 8 * j; const LAS float* s = scr + (8 * c) * 33 + n;
        u32x4 o; o.x = pk2(s[0 * 33], s[1 * 33]); o.y = pk2(s[2 * 33], s[3 * 33]); o.z = pk2(s[4 * 33], s[5 * 33]); o.w = pk2(s[6 * 33], s[7 * 33]);
        *(u32x4*)(WT + (size_t)(n0 + n) * K + k0 + 8 * c) = o; }
    asm volatile("s_waitcnt lgkmcnt(0)" ::: "memory");
}
__device__ __forceinline__ void convert_set(const Args& a, LAS unsigned char* lds, int l, int mask, int wid, int nw) {
    const int lane = TIDX & 63, wave = TIDX >> 6;
    LAS float* scr = (LAS float*)(lds + wave * 16384);
    unsigned char* ws = a.ws;
    const int I_IN = (mask & 1) ? (D / 64) * (NZ / 32) : 0, I_B0 = (mask & 2) ? (512 / 64) * (D / 32) : 0, I_B1 = (mask & 4) ? (512 / 64) * (D / 32) : 0, I_B2 = (mask & 8) ? (512 / 64) * (D / 32) : 0;
    const int I_OUT = (mask & 16) ? (D / 64) * (D / 32) : 0, I_UP = (mask & 32) ? (D / 64) * (NUP / 32) : 0, I_DN = (mask & 64) ? (DFF / 64) * (D / 32) : 0;
    const int NITEMS = I_IN + I_B0 + I_B1 + I_B2 + I_OUT + I_UP + I_DN;
    for (int it = wid; it < NITEMS; it += nw) {
        int r = it;
        if (r < I_IN) { transpose_item(a.w_in + (size_t)l * D * NZ, D, NZ, (bf16*)(ws + WS_WIN), scr, r, lane); continue; } r -= I_IN;
        if (r < I_B0) { transpose_item(a.w_br_hg + (size_t)l * 512 * D, 512, D, (bf16*)(ws + WS_WBR), scr, r, lane); continue; } r -= I_B0;
        if (r < I_B1) { transpose_item(a.w_br_sg + (size_t)l * 512 * D, 512, D, (bf16*)(ws + WS_WBR) + 1024 * 512, scr, r, lane); continue; } r -= I_B1;
        if (r < I_B2) { transpose_item(a.w_br_pool + (size_t)l * 512 * D, 512, D, (bf16*)(ws + WS_WBR) + 2 * 1024 * 512, scr, r, lane); continue; } r -= I_B2;
        if (r < I_OUT) { transpose_item(a.w_out + (size_t)l * D * D, D, D, (bf16*)(ws + WS_WOUT), scr, r, lane); continue; } r -= I_OUT;
        if (r < I_UP) { transpose_item(a.ffn_up + (size_t)l * D * NUP, D, NUP, (bf16*)(ws + WS_WUP), scr, r, lane); continue; } r -= I_UP;
        transpose_item(a.ffn_down + (size_t)l * DFF * D, DFF, D, (bf16*)(ws + WS_WDN), scr, r, lane);
    }
}
__device__ __forceinline__ void phase_mods(const Args& a, LAS unsigned char* lds) {
    const int tid = TIDX;
    LAS float* sc = (LAS float*)lds;
    LAS float* red = (LAS float*)(lds + 12288);
    float* mods = (float*)(a.ws + WS_MOD);
    for (int blk = blockIdx.x; blk < 256; blk += gridDim.x) {
        const int l = blk >> 7, n0 = (blk & 127) * 48;
        for (int i = tid; i < 3072; i += 512) { const int r = i >> 10, k = i & 1023; const float v = r == 0 ? a.c_ctx[k] : a.c[(r - 1) * 1024 + k]; sc[i] = silu_f(v); }
        __syncthreads();
        const int ks = tid / 12, c4 = tid - ks * 12;
        if (ks < 42) {
            const float* W = a.w_ada + (size_t)l * D * NMOD + n0 + 4 * c4;
            f32x4 a0 = (f32x4){0.f, 0.f, 0.f, 0.f}, a1 = a0, a2 = a0;
#pragma unroll 5
            for (int k = ks; k < 1024; k += 42) { const f32x4 wv = *(const f32x4*)(W + (size_t)k * NMOD); a0 += wv * sc[k]; a1 += wv * sc[1024 + k]; a2 += wv * sc[2048 + k]; }
            *(LAS f32x4*)(red + (ks * 3 + 0) * 48 + 4 * c4) = a0; *(LAS f32x4*)(red + (ks * 3 + 1) * 48 + 4 * c4) = a1; *(LAS f32x4*)(red + (ks * 3 + 2) * 48 + 4 * c4) = a2;
        }
        __syncthreads();
        if (tid < 144) { const int r = tid / 48, cc = tid - r * 48; float sm = 0.f;
            for (int w = 0; w < 42; ++w) sm += red[(w * 3 + r) * 48 + cc];
            mods[(l * 3 + r) * NMOD + n0 + cc] = sm + a.b_ada[l * NMOD + n0 + cc]; }
        __syncthreads();
    }
}
__device__ __forceinline__ void phase_norm(const Args& a, int l, const float* gain, int shift_off, bool first) {
    const int lane = TIDX & 63, wave = TIDX >> 6;
    const int gw = blockIdx.x * 8 + wave, NGW = gridDim.x * 8;
    const float* mods = (const float*)(a.ws + WS_MOD) + (size_t)l * 3 * NMOD;
    bf16* H = (bf16*)(a.ws + WS_H);
    f32x4 gn[4];
#pragma unroll
    for (int j = 0; j < 4; ++j) gn[j] = *(const f32x4*)(gain + 4 * (lane + 64 * j));
    for (int row = gw; row < M; row += NGW) {
        const int modrow = row < MP ? 0 : 1 + ((row - MP) >> 10);
        const float* src = first ? (row < MP ? a.x_prompt + (size_t)row * D : a.x_sample + (size_t)(row - MP) * D) : a.out + (size_t)row * D;
        f32x4 v[4]; float s = 0.f;
#pragma unroll
        for (int j = 0; j < 4; ++j) v[j] = *(const f32x4*)(src + 4 * (lane + 64 * j));
        if (first) {
            if (row >= MP) {
                const int n = (row - MP) & 1023; const float pr = (float)(n >> 6), pc = (float)(n & 63);
#pragma unroll
                for (int e = 0; e < 4; ++e) { const float om = expf(-(float)(4 * lane + e) * (9.210340371976184f / 256.f));
                    v[0][e] += sinf(pr * om); v[1][e] += cosf(pr * om); v[2][e] += sinf(pc * om); v[3][e] += cosf(pc * om); }
            }
#pragma unroll
            for (int j = 0; j < 4; ++j) *(f32x4*)(a.out + (size_t)row * D + 4 * (lane + 64 * j)) = v[j];
        }
#pragma unroll
        for (int j = 0; j < 4; ++j) s += (v[j][0] * v[j][0] + v[j][1] * v[j][1]) + (v[j][2] * v[j][2] + v[j][3] * v[j][3]);
        const float rstd = rsqrtf(wave_sum(s) * (1.f / D) + EPS);
        const float* mr = mods + modrow * NMOD + shift_off;
#pragma unroll
        for (int j = 0; j < 4; ++j) { const int c0 = 4 * (lane + 64 * j);
            const f32x4 sh = *(const f32x4*)(mr + c0), scl = *(const f32x4*)(mr + 1024 + c0);
            const f32x4 y = v[j] * rstd * gn[j] * (scl + 1.f) + sh;
            u32x2 o; o.x = pk2(y[0], y[1]); o.y = pk2(y[2], y[3]);
            *(u32x2*)(H + (size_t)row * D + c0) = o; }
    }
}
__device__ __forceinline__ void phase_final(const Args& a) {
    const int lane = TIDX & 63, wave = TIDX >> 6;
    const int gw = blockIdx.x * 8 + wave, NGW = gridDim.x * 8;
    f32x4 gn[4];
#pragma unroll
    for (int j = 0; j < 4; ++j) gn[j] = *(const f32x4*)(a.final_norm + 4 * (lane + 64 * j));
    for (int row = gw; row < M; row += NGW) {
        float* xr = a.out + (size_t)row * D;
        f32x4 v[4]; float s = 0.f;
#pragma unroll
        for (int j = 0; j < 4; ++j) { v[j] = *(const f32x4*)(xr + 4 * (lane + 64 * j)); s += (v[j][0] * v[j][0] + v[j][1] * v[j][1]) + (v[j][2] * v[j][2] + v[j][3] * v[j][3]); }
        const float rstd = rsqrtf(wave_sum(s) * (1.f / D) + EPS);
#pragma unroll
        for (int j = 0; j < 4; ++j) *(f32x4*)(xr + 4 * (lane + 64 * j)) = v[j] * rstd * gn[j];
    }
}

constexpr int SC_QT = 0, SC_KT = 4352, SC_QD = 8704, SC_KE = 13056, SC_VT = 18176, SC_AD = 23296, SC_BUF = 23808, SC_TOT = 2 * SC_BUF;
__device__ __forceinline__ s16x4 pack4(f32x4 v) { u32x2 p; p.x = pk2(v[0], v[1]); p.y = pk2(v[2], v[3]); return __builtin_bit_cast(s16x4, p); }
__device__ __forceinline__ void scan_item(const Args& a, LAS unsigned char* lds, int l, int s, int h, int d, int seg) {
    const int tid = TIDX, lane = tid & 63, w = tid >> 6, fr = lane & 15, fq = lane >> 4;
    const int k = (w & 1) * 64 + lane, tg = w >> 1;
    const int T = s < 32 ? 256 : 1024, base = s < 32 ? s * 256 : MP + (s - 32) * 1024, nch = 16, pos0 = 256 * seg;
    const bf16* Z = (const bf16*)(a.ws + WS_Z);
    bf16* OH = (bf16*)(a.ws + WS_H) + (size_t)d * M * 512;
    const int sidx = (((s - 32) * 4 + h) * 2 + d) * 4 + seg;
    bf16* QC = (bf16*)(a.ws + WS_QC) + (size_t)((((s - 32) * 4 + h) * 2 + d) * 1024) * 128;
    float run = 1.f;
    float lb = 0.f;
    if (l == 1) lb = sigm(a.lb_logits[(2 + d) * 512 + h * 128 + k] - a.lb_logits[d * 512 + h * 128 + k]);
    const float oml = 1.f - lb;
    f32x4 S[8];
    if (s >= 32 && seg == 0) { const float* st = a.state + ((((size_t)(s - 32) * 2 + l) * 2 + d) * 4 + h) * 16384;
#pragma unroll
        for (int r = 0; r < 8; ++r)
#pragma unroll
            for (int i = 0; i < 4; ++i) S[r][i] = st[(16 * r + 4 * fq + i) * 128 + 16 * w + fr];
    } else {
#pragma unroll
        for (int r = 0; r < 8; ++r) S[r] = (f32x4){0.f, 0.f, 0.f, 0.f};
    }
    LAS float* TOT = (LAS float*)(lds + SC_TOT);
    const int zcol_q = ZQ + h * 128 + k, zcol_f = ZFF + d * 512 + h * 128 + k, zcol_i = ZI + h * 128 + k;
    unsigned short nq[4], nf[4], ni[4];
#define SC_TOK(c, j) (d == 0 ? pos0 + 16 * (c) + (j) : T - 1 - pos0 - 16 * (c) - (j))
#define SC_ROW(c, j) (base + SC_TOK(c, j))
#define SC_BAR() do { asm volatile("s_waitcnt lgkmcnt(0)" ::: "memory"); __builtin_amdgcn_s_barrier(); asm volatile("" ::: "memory"); } while (0)
#pragma unroll
    for (int e = 0; e < 4; ++e) { const size_t ro = (size_t)SC_ROW(0, 4 * tg + e) * NZ; nq[e] = Z[ro + zcol_q]; nf[e] = Z[ro + zcol_f]; ni[e] = Z[ro + zcol_i]; }
    {
      for (int c = 0; c < nch; ++c) {
        float q[4], kk[4], pf[4], vv[4];
#pragma unroll
        for (int e = 0; e < 4; ++e) {
            const float zf = fmaxf(bf2f(nf[e]), -30.f), ex = __expf(-zf), sg = frcp(1.f + ex);
            pf[e] = lb + oml * sg; kk[e] = oml * ex * sg; q[e] = bf2f(nq[e]); vv[e] = bf2f(ni[e]);
        }
        if (c + 1 < nch) {
#pragma unroll
            for (int e = 0; e < 4; ++e) { const size_t ro = (size_t)SC_ROW(c + 1, 4 * tg + e) * NZ; nq[e] = Z[ro + zcol_q]; nf[e] = Z[ro + zcol_f]; ni[e] = Z[ro + zcol_i]; }
        }
        pf[1] *= pf[0]; pf[2] *= pf[1]; pf[3] *= pf[2];
        TOT[tg * 128 + k] = pf[3];
        SC_BAR();
        const float t0 = TOT[k], t1 = TOT[128 + k], t2 = TOT[256 + k], t3 = TOT[384 + k];
        const float off = (tg > 0 ? t0 : 1.f) * (tg > 1 ? t1 : 1.f) * (tg > 2 ? t2 : 1.f), pref = t0 * t1, p15 = pref * (t2 * t3);
        const float ipref = frcp(fmaxf(pref, 1e-30f));
        LAS unsigned char* B = lds + (c & 1) * SC_BUF;
        float ke[4];
#pragma unroll
        for (int e = 0; e < 4; ++e) { const float P = off * pf[e], iP = frcp(fmaxf(P, 1e-30f)); const int j = 4 * tg + e;
            const unsigned w0 = pk2(q[e] * (P * ipref), kk[e] * (pref * iP)), w1 = pk2(q[e] * P, 0.f);
            ((LAS bf16*)(B + SC_QT))[j * 136 + k] = (bf16)(w0 & 0xffffu);
            ((LAS bf16*)(B + SC_KT))[j * 136 + k] = (bf16)(w0 >> 16);
            ((LAS bf16*)(B + SC_QD))[j * 136 + k] = (bf16)(w1 & 0xffffu);
            if (s >= 32) QC[(size_t)SC_TOK(c, j) * 128 + k] = (bf16)(pk2(q[e] * P * run, 0.f) & 0xffffu);
            ke[e] = kk[e] * (p15 * iP); }
        run *= p15;
        { u32x2 p; p.x = pk2(ke[0], ke[1]); p.y = pk2(ke[2], ke[3]); *(LAS u32x2*)(B + SC_KE + k * 40 + tg * 8) = p;
          p.x = pk2(vv[0], vv[1]); p.y = pk2(vv[2], vv[3]); *(LAS u32x2*)(B + SC_VT + k * 40 + tg * 8) = p; }
        if (tg == 0) ((LAS float*)(B + SC_AD))[k] = p15;
        SC_BAR();
        f32x4 pt = (f32x4){0.f, 0.f, 0.f, 0.f};
#pragma unroll
        for (int k4 = 0; k4 < 4; ++k4) {
            const bf16x8 ka = *(const LAS bf16x8*)(B + SC_KT + fr * 272 + k4 * 64 + fq * 16);
            const bf16x8 qb = *(const LAS bf16x8*)(B + SC_QT + fr * 272 + k4 * 64 + fq * 16);
            pt = __builtin_amdgcn_mfma_f32_16x16x32_bf16(ka, qb, pt, 0, 0, 0);
        }
#pragma unroll
        for (int i = 0; i < 4; ++i) if (4 * fq + i > fr) pt[i] = 0.f;
        const s16x4 pa = pack4(pt);
        const s16x4 vb = *(const LAS s16x4*)(B + SC_VT + (16 * w + fr) * 40 + fq * 8);
        f32x4 o = __builtin_amdgcn_mfma_f32_16x16x16bf16_1k(pa, vb, (f32x4){0.f, 0.f, 0.f, 0.f}, 0, 0, 0);
#pragma unroll
        for (int r = 0; r < 8; ++r) {
            const s16x4 qa = *(const LAS s16x4*)(B + SC_QD + fr * 272 + r * 32 + fq * 8);
            o = __builtin_amdgcn_mfma_f32_16x16x16bf16_1k(qa, pack4(S[r]), o, 0, 0, 0);
        }
#pragma unroll
        for (int r = 0; r < 8; ++r) {
            const f32x4 ad = *(const LAS f32x4*)(B + SC_AD + (16 * r + 4 * fq) * 4);
            const s16x4 ka = *(const LAS s16x4*)(B + SC_KE + (16 * r + fr) * 40 + fq * 8);
            S[r] = __builtin_amdgcn_mfma_f32_16x16x16bf16_1k(ka, vb, S[r] * ad, 0, 0, 0);
        }
#pragma unroll
        for (int i = 0; i < 4; ++i) OH[(size_t)SC_ROW(c, 4 * fq + i) * 512 + h * 128 + 16 * w + fr] = (bf16)(pk2(o[i], 0.f) & 0xffffu);
      }
    }
#undef SC_ROW
#undef SC_TOK
#undef SC_BAR
    if (s >= 32) { float* sl = (float*)(a.ws + WS_SL) + (size_t)sidx * 16384;
#pragma unroll
        for (int r = 0; r < 8; ++r)
#pragma unroll
            for (int i = 0; i < 4; ++i) sl[(16 * r + 4 * fq + i) * 128 + 16 * w + fr] = S[r][i];
        if (tg == 0) ((float*)(a.ws + WS_AS))[sidx * 128 + k] = run; }
    if (s < 32) { float* st = a.out + (size_t)M * D + ((((size_t)s * 2 + l) * 2 + d) * 4 + h) * 16384;
#pragma unroll
        for (int r = 0; r < 8; ++r)
#pragma unroll
            for (int i = 0; i < 4; ++i) st[(16 * r + 4 * fq + i) * 128 + 16 * w + fr] = S[r][i]; }
    __syncthreads();
}
__device__ __forceinline__ void mm128(const LAS bf16* As, const LAS bf16* Bs, f32x4 (&acc)[2][4], int wr, int wc, int fr, int fq, bool zero = true) {
    if (zero) {
#pragma unroll
    for (int mt = 0; mt < 2; ++mt)
#pragma unroll
        for (int nt = 0; nt < 4; ++nt) acc[mt][nt] = (f32x4){0.f, 0.f, 0.f, 0.f}; }
#pragma unroll
    for (int k4 = 0; k4 < 4; ++k4) {
        bf16x8 af[2];
#pragma unroll
        for (int mt = 0; mt < 2; ++mt) af[mt] = *(const LAS bf16x8*)(As + (32 * wr + 16 * mt + fr) * 136 + 32 * k4 + 8 * fq);
#pragma unroll
        for (int nt = 0; nt < 4; ++nt) {
            const bf16x8 bfr = *(const LAS bf16x8*)(Bs + (64 * wc + 16 * nt + fr) * 136 + 32 * k4 + 8 * fq);
#pragma unroll
            for (int mt = 0; mt < 2; ++mt) acc[mt][nt] = __builtin_amdgcn_mfma_f32_16x16x32_bf16(af[mt], bfr, acc[mt][nt], 0, 0, 0);
        }
    }
}
__device__ __forceinline__ void stage_f32_tile(const float* W, LAS bf16* T) {
#pragma unroll
    for (int it = 0; it < 8; ++it) { const int idx = TIDX * 4 + 2048 * it, r = idx >> 7, cc = idx & 127;
        const f32x4 v = *(const f32x4*)(W + idx); u32x2 o; o.x = pk2(v[0], v[1]); o.y = pk2(v[2], v[3]); *(LAS u32x2*)(T + r * 136 + cc) = o; }
}
__device__ __forceinline__ void stage_f32_tile_T(const float* W, LAS bf16* T) {
#pragma unroll
    for (int it = 0; it < 4; ++it) { const int p = TIDX + 512 * it, n = p & 127, k0 = (p >> 7) * 8;
        float v[8];
#pragma unroll
        for (int e = 0; e < 8; ++e) v[e] = W[(size_t)(k0 + e) * 128 + n];
        u32x4 o; o.x = pk2(v[0], v[1]); o.y = pk2(v[2], v[3]); o.z = pk2(v[4], v[5]); o.w = pk2(v[6], v[7]);
        *(LAS u32x4*)(T + n * 136 + k0) = o; }
}
__device__ __forceinline__ void sg_item(const Args& a, LAS unsigned char* lds, int l, int ci) {
    const int tid = TIDX, lane = tid & 63, w = tid >> 6, fr = lane & 15, fq = lane >> 4, wr = w >> 1, wc = w & 1;
    const int r0 = ci * 128;
    const bf16* Z = (const bf16*)(a.ws + WS_Z);
    bf16* O = (bf16*)(a.ws + WS_O3) + (size_t)M * 512;
    LAS bf16* As = (LAS bf16*)lds; LAS bf16* Bs = (LAS bf16*)(lds + 34816); LAS float* rstd = (LAS float*)(lds + 69632);
    { u32x4 zz[16];
#pragma unroll
      for (int rr = 0; rr < 16; ++rr) zz[rr] = *(const u32x4*)(Z + (size_t)(r0 + 16 * w + rr) * NZ + ZV + 8 * lane);
#pragma unroll
      for (int rr = 0; rr < 16; ++rr) { float ss = 0.f;
#pragma unroll
        for (int e = 0; e < 4; ++e) { const float g0 = bflo(zz[rr][e]), g1 = bfhi(zz[rr][e]); ss += g0 * g0 + g1 * g1; }
        ss = wave_sum(ss); if (lane == 0) rstd[16 * w + rr] = rsqrtf(ss * (1.f / 512.f) + EPS); } }
    __syncthreads();
    f32x4 ra[8]; unsigned short rb[4][8]; float rgn[4];
#define SG_PREFETCH(gg) do { \
        _Pragma("unroll") for (int it = 0; it < 8; ++it) ra[it] = *(const f32x4*)(a.sg_w + ((size_t)l * 4 + (gg)) * 16384 + tid * 4 + 2048 * it); \
        _Pragma("unroll") for (int it = 0; it < 4; ++it) { const int p = tid + 512 * it, c = p & 127, s0 = (p >> 7) * 8; rgn[it] = a.sg_norm[l * 512 + (gg) * 128 + c]; \
            _Pragma("unroll") for (int e = 0; e < 8; ++e) rb[it][e] = Z[(size_t)(r0 + s0 + e) * NZ + ZV + (gg) * 128 + c]; } } while (0)
    SG_PREFETCH(0);
    for (int g = 0; g < 4; ++g) {
#pragma unroll
        for (int it = 0; it < 8; ++it) { const int idx = tid * 4 + 2048 * it, r = idx >> 7, cc = idx & 127;
            u32x2 o; o.x = pk2(ra[it][0], ra[it][1]); o.y = pk2(ra[it][2], ra[it][3]); *(LAS u32x2*)(As + r * 136 + cc) = o; }
#pragma unroll
        for (int it = 0; it < 4; ++it) { const int p = tid + 512 * it, c = p & 127, s0 = (p >> 7) * 8;
            float v[8];
#pragma unroll
            for (int e = 0; e < 8; ++e) v[e] = bf2f(rb[it][e]) * rstd[s0 + e] * rgn[it];
            u32x4 o; o.x = pk2(v[0], v[1]); o.y = pk2(v[2], v[3]); o.z = pk2(v[4], v[5]); o.w = pk2(v[6], v[7]);
            *(LAS u32x4*)(Bs + c * 136 + s0) = o; }
        __syncthreads();
        if (g + 1 < 4) SG_PREFETCH(g + 1);
        f32x4 acc[2][4]; mm128(As, Bs, acc, wr, wc, fr, fq);
        { unsigned short uu[2][4][4]; float bias[2][4];
#pragma unroll
          for (int mt = 0; mt < 2; ++mt)
#pragma unroll
            for (int i = 0; i < 4; ++i) { const int row = 32 * wr + 16 * mt + 4 * fq + i; bias[mt][i] = a.sg_b[(l * 4 + g) * 128 + row];
#pragma unroll
                for (int nt = 0; nt < 4; ++nt) uu[mt][i][nt] = Z[(size_t)(r0 + row) * NZ + ZU + g * 128 + 64 * wc + 16 * nt + fr]; }
#pragma unroll
          for (int mt = 0; mt < 2; ++mt)
#pragma unroll
            for (int i = 0; i < 4; ++i) { const int row = 32 * wr + 16 * mt + 4 * fq + i;
#pragma unroll
                for (int nt = 0; nt < 4; ++nt) { const int col = g * 128 + 64 * wc + 16 * nt + fr;
                    O[(size_t)(r0 + row) * 512 + col] = (bf16)(pk2(bf2f(uu[mt][i][nt]) * (acc[mt][nt][i] + bias[mt][i]), 0.f) & 0xffffu); } } }
        __syncthreads();
    }
#undef SG_PREFETCH
}
__device__ __forceinline__ void pool_item(const Args& a, LAS unsigned char* lds, int l, int ci) {
    const int tid = TIDX, lane = tid & 63, w = tid >> 6, fr = lane & 15, fq = lane >> 4, wr = w >> 1, wc = w & 1;
    const int r0 = ci * 128;
    const int T = r0 < MP ? 256 : 1024, base = r0 < MP ? (r0 & ~255) : MP + ((r0 - MP) & ~1023), t0 = r0 - base;
    const bf16* Z = (const bf16*)(a.ws + WS_Z);
    bf16* O = (bf16*)(a.ws + WS_O3) + (size_t)2 * M * 512;
    LAS bf16* As = (LAS bf16*)lds; LAS bf16* Bs = (LAS bf16*)(lds + 34816); LAS bf16* Ts = (LAS bf16*)(lds + 69632);
    const int c = tid & 127, seg = tid >> 7;
    u32x4 ptv[5];
#define POOL_PREFETCH(gg) do { \
        _Pragma("unroll") for (int it = 0; it < 5; ++it) { const int ch = tid + 512 * it; const int rr = ch >> 4, c8 = (ch & 15) * 8, tau = t0 - 8 + rr; \
            ptv[it] = (ch < 2304 && tau >= 0 && tau < T) ? *(const u32x4*)(Z + (size_t)(base + tau) * NZ + ZP + (gg) * 128 + c8) : (u32x4){0u, 0u, 0u, 0u}; } } while (0)
    POOL_PREFETCH(0);
    for (int g = 0; g < 4; ++g) {
        const int hw = 1 << g;
        stage_f32_tile_T(a.pool_w + ((size_t)l * 4 + g) * 16384, Bs);
#pragma unroll
        for (int it = 0; it < 5; ++it) { const int ch = tid + 512 * it;
            if (ch < 2304) { const int rr = ch >> 4, c8 = (ch & 15) * 8; *(LAS u32x4*)(Ts + rr * 136 + c8) = ptv[it]; } }
        __syncthreads();
        if (g + 1 < 4) POOL_PREFETCH(g + 1);
        {
            const int ts = t0 + 32 * seg;
            const LAS bf16* tp = Ts + (32 * seg + 8) * 136 + c;
            float sum = 0.f;
            for (int dd = -hw; dd < hw; ++dd) sum += bf2f(tp[dd * 136]);
#pragma unroll 8
            for (int tt = 0; tt < 32; ++tt) { const int t = ts + tt;
                const int lo = t - hw < 0 ? 0 : t - hw, hi = t + hw > T ? T : t + hw;
                const float cur = bf2f(tp[tt * 136]);
                As[(32 * seg + tt) * 136 + c] = (bf16)(pk2(sum * frcp((float)(hi - lo)) - cur, 0.f) & 0xffffu);
                sum += bf2f(tp[(tt + hw) * 136]) - bf2f(tp[(tt - hw) * 136]); }
        }
        __syncthreads();
        f32x4 acc[2][4]; mm128(As, Bs, acc, wr, wc, fr, fq);
#pragma unroll
        for (int nt = 0; nt < 4; ++nt) { const int col = g * 128 + 64 * wc + 16 * nt + fr; const float sc = a.pool_scale[l * 512 + col];
#pragma unroll
            for (int mt = 0; mt < 2; ++mt)
#pragma unroll
                for (int i = 0; i < 4; ++i) { const int row = 32 * wr + 16 * mt + 4 * fq + i; O[(size_t)(r0 + row) * 512 + col] = (bf16)(pk2(acc[mt][nt][i] * sc, 0.f) & 0xffffu); } }
        __syncthreads();
    }
#undef POOL_PREFETCH
}
__device__ __forceinline__ void phase_mixers(const Args& a, LAS unsigned char* lds, int l) {
    for (int it = blockIdx.x; it < 480; it += (int)gridDim.x) {
        if (it < 256) { for (int rp = 0; rp <= ((REPMASK >> 10) & 1); ++rp) scan_item(a, lds, l, it >> 3, (it >> 1) & 3, it & 1, 0); }
        else if (it < 320) { const int p = it - 256; for (int rp = 0; rp <= ((REPMASK >> 10) & 1); ++rp) scan_item(a, lds, l, 32 + (p >> 5), (p >> 3) & 3, (p >> 2) & 1, p & 3); }
        else if (it < 400) { for (int rp = 0; rp <= ((REPMASK >> 11) & 1); ++rp) sg_item(a, lds, l, it - 320); }
        else { for (int rp = 0; rp <= ((REPMASK >> 12) & 1); ++rp) pool_item(a, lds, l, it - 400); }
    }
    for (int rp = 0; rp < ((REPMASK >> 13) & 1); ++rp) convert_set(a, lds, l, l == 0 ? 0x7e : 0x40, (int)blockIdx.x * 8 + (TIDX >> 6), (int)gridDim.x * 8);
    if (l == 0) convert_set(a, lds, 0, 0x1e, (int)blockIdx.x * 8 + (TIDX >> 6), (int)gridDim.x * 8);
}
__device__ __forceinline__ void phase_combine(const Args& a, int l, int bidx, int nblk) {
    const int lane = TIDX & 63, wave = TIDX >> 6;
    const int gw = bidx * 8 + wave, NGW = nblk * 8;
    const bf16* Z = (const bf16*)(a.ws + WS_Z); const bf16* OF = (const bf16*)(a.ws + WS_H); const bf16* OB = OF + (size_t)M * 512;
    bf16* O = (bf16*)(a.ws + WS_O3);
    const int c8 = 8 * lane;
    const f32x4 g0 = *(const f32x4*)(a.hg_norm + l * 128 + (c8 & 127)), g1 = *(const f32x4*)(a.hg_norm + l * 128 + (c8 & 127) + 4);
    for (int row = gw; row < MP; row += NGW) {
        const u32x4 f = *(const u32x4*)(OF + (size_t)row * 512 + c8), bb = *(const u32x4*)(OB + (size_t)row * 512 + c8), zg = *(const u32x4*)(Z + (size_t)row * NZ + ZG + c8);
        float v[8], ss = 0.f;
#pragma unroll
        for (int e = 0; e < 4; ++e) { v[2 * e] = bflo(f[e]) + bflo(bb[e]); v[2 * e + 1] = bfhi(f[e]) + bfhi(bb[e]); ss += v[2 * e] * v[2 * e] + v[2 * e + 1] * v[2 * e + 1]; }
        ss += __shfl_xor(ss, 1); ss += __shfl_xor(ss, 2); ss += __shfl_xor(ss, 4); ss += __shfl_xor(ss, 8);
        const float r = rsqrtf(ss * (1.f / 128.f) + EPS);
        u32x4 o;
        o.x = pk2(v[0] * r * g0[0] * bflo(zg.x), v[1] * r * g0[1] * bfhi(zg.x));
        o.y = pk2(v[2] * r * g0[2] * bflo(zg.y), v[3] * r * g0[3] * bfhi(zg.y));
        o.z = pk2(v[4] * r * g1[0] * bflo(zg.z), v[5] * r * g1[1] * bfhi(zg.z));
        o.w = pk2(v[6] * r * g1[2] * bflo(zg.w), v[7] * r * g1[3] * bfhi(zg.w));
        *(u32x4*)(O + (size_t)row * 512 + c8) = o;
    }
}
__device__ __forceinline__ void sample_combine_item(const Args& a, LAS unsigned char* lds, int l, int sq, int tseg, int h, int hf0) {
    const int tid = TIDX, lane = tid & 63, w = tid >> 6, fr = lane & 15, fq = lane >> 4, wr = w >> 1, wc = w & 1;
    LAS bf16* As = (LAS bf16*)lds; LAS bf16* Bs = (LAS bf16*)(lds + 34816); LAS float* Ct = (LAS float*)lds;
    const bf16* Z = (const bf16*)(a.ws + WS_Z); const bf16* OF = (const bf16*)(a.ws + WS_H); const bf16* OB = OF + (size_t)M * 512;
    bf16* O = (bf16*)(a.ws + WS_O3);
    const float* SL = (const float*)(a.ws + WS_SL); const float* AS = (const float*)(a.ws + WS_AS);
    const int hf = hf0;
    f32x4 acc[2][4];
#pragma unroll
    for (int mt = 0; mt < 2; ++mt)
#pragma unroll
        for (int nt = 0; nt < 4; ++nt) acc[mt][nt] = (f32x4){0.f, 0.f, 0.f, 0.f};
    for (int d = 0; d < 2; ++d) {
        const int g = d == 0 ? tseg : 3 - tseg;
        if (g == 0) continue;
        const int ib = ((sq * 4 + h) * 2 + d) * 4;
#pragma unroll
        for (int it = 0; it < 4; ++it) { const int p = tid + 512 * it, v = p & 127, k0 = (p >> 7) * 8;
            float E[8];
#pragma unroll
            for (int e = 0; e < 8; ++e) E[e] = SL[(size_t)ib * 16384 + (k0 + e) * 128 + v];
            for (int gg = 1; gg < g; ++gg) {
#pragma unroll
                for (int e = 0; e < 8; ++e) E[e] = E[e] * AS[(ib + gg) * 128 + k0 + e] + SL[(size_t)(ib + gg) * 16384 + (k0 + e) * 128 + v]; }
            u32x4 o; o.x = pk2(E[0], E[1]); o.y = pk2(E[2], E[3]); o.z = pk2(E[4], E[5]); o.w = pk2(E[6], E[7]);
            *(LAS u32x4*)(Bs + v * 136 + k0) = o; }
        const bf16* QC = (const bf16*)(a.ws + WS_QC) + (size_t)(((sq * 4 + h) * 2 + d) * 1024 + 256 * tseg) * 128;
        {
#pragma unroll
            for (int it = 0; it < 4; ++it) { const int ch = tid + 512 * it, r = ch >> 4, c8 = (ch & 15) * 8;
                *(LAS u32x4*)(As + r * 136 + c8) = *(const u32x4*)(QC + (size_t)(128 * hf + r) * 128 + c8); }
            __syncthreads();
            mm128(As, Bs, acc, wr, wc, fr, fq, false);
            __syncthreads();
        }
    }
    const float gn0 = a.hg_norm[l * 128 + 2 * lane], gn1 = a.hg_norm[l * 128 + 2 * lane + 1];
    {
#pragma unroll
        for (int mt = 0; mt < 2; ++mt)
#pragma unroll
            for (int nt = 0; nt < 4; ++nt)
#pragma unroll
                for (int i = 0; i < 4; ++i) Ct[(32 * wr + 16 * mt + 4 * fq + i) * 132 + 64 * wc + 16 * nt + fr] = acc[mt][nt][i];
        __syncthreads();
        { unsigned pf_[16], pb_[16], zg[16];
          const int grow0 = MP + sq * 1024 + 256 * tseg + 128 * hf + 16 * w;
#pragma unroll
          for (int rr = 0; rr < 16; ++rr) { const size_t go = (size_t)(grow0 + rr) * 512 + h * 128 + 2 * lane;
              pf_[rr] = *(const unsigned*)(OF + go); pb_[rr] = *(const unsigned*)(OB + go); zg[rr] = *(const unsigned*)(Z + (size_t)(grow0 + rr) * NZ + ZG + h * 128 + 2 * lane); }
#pragma unroll
          for (int rr = 0; rr < 16; ++rr) { const int r = 16 * w + rr; const size_t go = (size_t)(grow0 + rr) * 512 + h * 128 + 2 * lane;
              const float v0 = Ct[r * 132 + 2 * lane] + bflo(pf_[rr]) + bflo(pb_[rr]), v1 = Ct[r * 132 + 2 * lane + 1] + bfhi(pf_[rr]) + bfhi(pb_[rr]);
              const float rs = rsqrtf(wave_sum(v0 * v0 + v1 * v1) * (1.f / 128.f) + EPS);
              *(unsigned*)(O + go) = pk2(v0 * rs * gn0 * bflo(zg[rr]), v1 * rs * gn1 * bfhi(zg[rr])); } }
        __syncthreads();
    }
}
__device__ __forceinline__ void phase_conv(const Args& a, int l) {
    const bf16* HF = (const bf16*)(a.ws + WS_Z); bf16* ACT = (bf16*)(a.ws + WS_O3);
    const float* cw = a.conv_w + (size_t)l * 3 * NUP; const float* cb = a.conv_b + (size_t)l * NUP;
    const int total = (M / 8) * 352;
    for (int idx = blockIdx.x * 512 + TIDX; idx < total; idx += (int)gridDim.x * 512) {
        const int run = idx / 352, j0 = (idx - run * 352) * 8, row0 = run * 8;
        const int t0 = row0 < MP ? (row0 & 255) : ((row0 - MP) & 1023), T = row0 < MP ? 256 : 1024;
        float r[2][8][8];
#pragma unroll
        for (int hf = 0; hf < 2; ++hf) { const int col = hf * DFF + j0; const bf16* hp0 = HF + (size_t)row0 * NUP + col;
            u32x4 h[10];
#pragma unroll
            for (int q = 0; q < 10; ++q) { const int t = t0 - 1 + q; h[q] = (t >= 0 && t < T) ? *(const u32x4*)(hp0 + (ptrdiff_t)(q - 1) * NUP) : (u32x4){0u, 0u, 0u, 0u}; }
            const f32x4 wa0 = *(const f32x4*)(cw + col), wa1 = *(const f32x4*)(cw + col + 4), wb0 = *(const f32x4*)(cw + NUP + col), wb1 = *(const f32x4*)(cw + NUP + col + 4);
            const f32x4 wc0 = *(const f32x4*)(cw + 2 * NUP + col), wc1 = *(const f32x4*)(cw + 2 * NUP + col + 4), bi0 = *(const f32x4*)(cb + col), bi1 = *(const f32x4*)(cb + col + 4);
#pragma unroll
            for (int e = 0; e < 4; ++e) {
                const float w0l = e < 2 ? wa0[2 * e] : wa1[2 * e - 4], w0h = e < 2 ? wa0[2 * e + 1] : wa1[2 * e - 3];
                const float w1l = e < 2 ? wb0[2 * e] : wb1[2 * e - 4], w1h = e < 2 ? wb0[2 * e + 1] : wb1[2 * e - 3];
                const float w2l = e < 2 ? wc0[2 * e] : wc1[2 * e - 4], w2h = e < 2 ? wc0[2 * e + 1] : wc1[2 * e - 3];
                const float bl = e < 2 ? bi0[2 * e] : bi1[2 * e - 4], bh = e < 2 ? bi0[2 * e + 1] : bi1[2 * e - 3];
#pragma unroll
                for (int q = 0; q < 8; ++q) {
                    r[hf][q][2 * e] = w0l * bflo(h[q][e]) + w1l * bflo(h[q + 1][e]) + w2l * bflo(h[q + 2][e]) + bl;
                    r[hf][q][2 * e + 1] = w0h * bfhi(h[q][e]) + w1h * bfhi(h[q + 1][e]) + w2h * bfhi(h[q + 2][e]) + bh; } } }
#pragma unroll
        for (int q = 0; q < 8; ++q) { u32x4 o;
            o.x = pk2(silu_f(r[0][q][0]) * r[1][q][0], silu_f(r[0][q][1]) * r[1][q][1]); o.y = pk2(silu_f(r[0][q][2]) * r[1][q][2], silu_f(r[0][q][3]) * r[1][q][3]);
            o.z = pk2(silu_f(r[0][q][4]) * r[1][q][4], silu_f(r[0][q][5]) * r[1][q][5]); o.w = pk2(silu_f(r[0][q][6]) * r[1][q][6], silu_f(r[0][q][7]) * r[1][q][7]);
            *(u32x4*)(ACT + (size_t)(row0 + q) * DFF + j0) = o; }
    }
}

#define XB_TMO      128
#define XB_XCNT(j)  (256  + 64 * (j))
#define XB_XSUB(j)  (1280 + 64 * (j))
#define XB_XGEN(j)  (2304 + 64 * (j))
#define XB_TOP      3328
#define XB_TOPGEN   3392
#define XCD_BAR_WORDS 3456
#define XB_SPIN_CAP (1u << 18)

__device__ __forceinline__ unsigned xb_ld(unsigned* p)              { return __hip_atomic_load(p, __ATOMIC_RELAXED, __HIP_MEMORY_SCOPE_AGENT); }
__device__ __forceinline__ unsigned xb_add(unsigned* p, unsigned v) { return __hip_atomic_fetch_add(p, v, __ATOMIC_RELAXED, __HIP_MEMORY_SCOPE_AGENT); }
__device__ __forceinline__ unsigned xb_xcc_id() { return (unsigned)__builtin_amdgcn_s_getreg((3 << 11) | 20) & 0xFu; }
#define XB_SPIN(cond, bar) do { unsigned _sp = 0; while (cond) { __builtin_amdgcn_s_sleep(1); \
    if ((++_sp & 255u) == 0u) { if (xb_ld(&(bar)[XB_TMO])) break; if (_sp > XB_SPIN_CAP) { atomicAdd(&(bar)[XB_TMO], 1u); break; } } } } while (0)

struct XcdBarrier {
    unsigned* bar; unsigned x;
    volatile LAS unsigned* st;
};

__device__ __forceinline__ XcdBarrier xcd_barrier_post(unsigned* bar, volatile LAS unsigned* st) {
    XcdBarrier b; b.bar = bar; b.x = xb_xcc_id(); b.st = st;
    if (threadIdx.x == 0) (void)xb_add(&bar[XB_XCNT(b.x)], 1u);
    return b;
}
__device__ __forceinline__ void xcd_barrier_complete(unsigned* bar, unsigned x, unsigned& nloc, unsigned& nx) {
    const unsigned G = gridDim.x * gridDim.y * gridDim.z;
    unsigned sum, cnt, mine, sp = 0u;
    for (;;) {
        sum = 0u; cnt = 0u; mine = 0u;
#pragma unroll
        for (unsigned j = 0; j < 16; ++j) { const unsigned c = xb_ld(&bar[XB_XCNT(j)]); sum += c; cnt += (c > 0u) ? 1u : 0u; mine = (j == x) ? c : mine; }
        if (sum == G) break;
        __builtin_amdgcn_s_sleep(1);
        if ((++sp & 255u) == 0u) { if (xb_ld(&bar[XB_TMO])) break; if (sp > XB_SPIN_CAP) { atomicAdd(&bar[XB_TMO], 1u); break; } }
    }
    nloc = mine > 0u ? mine : 1u; nx = cnt > 0u ? cnt : 1u;
}

__device__ __forceinline__ void xcd_barrier(const XcdBarrier& b) {
    asm volatile("s_waitcnt vmcnt(0)" ::: "memory");
    __syncthreads();
    if (threadIdx.x == 0) {
        unsigned* bar = b.bar;
        __builtin_amdgcn_s_waitcnt(0);
        unsigned nloc = b.st[0], nx = b.st[1];
        if (nloc == 0u) { xcd_barrier_complete(bar, b.x, nloc, nx); b.st[0] = nloc; b.st[1] = nx; }
        const unsigned old = xb_add(&bar[XB_XSUB(b.x)], 1u);
        const unsigned gen = old / nloc;
        if (old + 1u == (gen + 1u) * nloc) {
            __builtin_amdgcn_fence(__ATOMIC_RELEASE, "agent");
            asm volatile("s_waitcnt vmcnt(0)" ::: "memory");
            const unsigned og = xb_add(&bar[XB_TOP], 1u);
            const unsigned tg = og / nx;
            if (og + 1u == (tg + 1u) * nx) xb_add(&bar[XB_TOPGEN], 1u);
            else XB_SPIN(xb_ld(&bar[XB_TOPGEN]) == tg, bar);
            __builtin_amdgcn_fence(__ATOMIC_ACQUIRE, "agent");
            xb_add(&bar[XB_XGEN(b.x)], 1u);
            asm volatile("s_waitcnt vmcnt(0)" ::: "memory");
        } else {
            XB_SPIN(xb_ld(&bar[XB_XGEN(b.x)]) == gen, bar);
            __builtin_amdgcn_fence(__ATOMIC_ACQUIRE, "agent");
            asm volatile("s_waitcnt vmcnt(0)" ::: "memory");
        }
    }
    __syncthreads();
}

__global__ void __launch_bounds__(512, 2) fwd_kernel(Args a) {
    extern __shared__ __attribute__((aligned(16))) unsigned char lds_raw[];
    LAS unsigned char* lds = (LAS unsigned char*)lds_raw;
    cg::grid_group grid = cg::this_grid();
    unsigned char* ws = a.ws;
    const int G = gridDim.x, bid = blockIdx.x;
    if (threadIdx.x < 4) ((volatile LAS unsigned*)(lds + 131072 + 64))[threadIdx.x] = 0u;
    __syncthreads();
    const XcdBarrier bar = xcd_barrier_post((unsigned*)(a.ws + WS_BAR), (volatile LAS unsigned*)(lds + 131072 + 64));
    for (int ph = a.ph_lo; ph < a.ph_hi; ++ph) {
        if (ph == 0 && PHSEL(100)) { phase_mods(a, lds); convert_set(a, lds, 0, 1, bid * 8 + (TIDX >> 6), G * 8); }
        else if (ph == NPHASE - 1 && PHSEL(101)) { phase_final(a); }
        else {
            const int l = (ph - 1) / 10, sp = (ph - 1) % 10;
            for (int rep = 0; rep <= ((REPMASK >> sp) & 1); ++rep) {
            const float* mods = (const float*)(ws + WS_MOD) + (size_t)l * 3 * NMOD;
            if ((sp == 0 || sp == 6) && PHSEL(0)) { phase_norm(a, l, (sp == 0 ? a.norm_mix : a.norm_ffn) + l * D, sp == 0 ? 0 : 3 * D, sp == 0 && l == 0); }
            else if ((sp == 1 || sp == 7) && PHSEL(1)) {
                const bool up = sp == 7;
                pg8::Gemm g{(const bf16*)(ws + WS_H), (const bf16*)(ws + (up ? WS_WUP : WS_WIN)), M, up ? NUP : NZ, D}; pg8::StaticOrder S; S.init(M, up ? NUP : NZ, G, bid);
                pg8::EpiZ E{(bf16*)(ws + WS_Z), up ? NUP : NZ, up ? 1 : 0}; pg8::gemm_phase<pg8::EpiZ, pg8::StaticOrder, true, true>(lds, g, S, E); }
            else if (sp == 2 && PHSEL(2)) { phase_mixers(a, lds, l); }
            else if (sp == 3 && PHSEL(3)) { if (bid < 64) sample_combine_item(a, lds, l, bid >> 5, (bid >> 3) & 3, (bid >> 1) & 3, bid & 1); else phase_combine(a, l, bid - 64, G - 64); }
            else if (sp == 4 && PHSEL(4)) { pg8::Gemm g{(const bf16*)(ws + WS_O3), (const bf16*)(ws + WS_WBR), M, D, 512}; pg8::TileOrder S{bid, 3};
                pg8::EpiBranch E{(const bf16*)(ws + WS_Z), (bf16*)(ws + WS_H)}; pg8::gemm_phase<pg8::EpiBranch, pg8::TileOrder, true, true>(lds, g, S, E);
                if ((bid >> 3) >= 20) convert_set(a, lds, l, l == 0 ? 0x60 : 0x40, ((bid >> 3) - 20) * 64 + (bid & 7) * 8 + (TIDX >> 6), 12 * 64); }
            else if ((sp == 5 || sp == 9) && PHSEL(5)) {
                const bool dn = sp == 9;
                pg8::Gemm g{(const bf16*)(ws + (dn ? WS_O3 : WS_H)), (const bf16*)(ws + (dn ? WS_WDN : WS_WOUT)), M, D, dn ? DFF : D}; pg8::TileOrder S{bid, 1};
                pg8::EpiResid E{a.out, mods + (dn ? 5 * D : 2 * D)}; pg8::gemm_phase<pg8::EpiResid, pg8::TileOrder, true, true>(lds, g, S, E);
                if (dn && l == 0 && (bid >> 3) >= 20) convert_set(a, lds, 1, 0x3f, ((bid >> 3) - 20) * 64 + (bid & 7) * 8 + (TIDX >> 6), 12 * 64); }
            else if (sp == 8 && PHSEL(8)) { phase_conv(a, l); }
            }
        }
        if (ph + 1 < a.ph_hi) { if (a.ph_hi > 1000) grid.sync(); else xcd_barrier(bar); }
    }
}

extern "C" void kernel_launch(void* const* d_in, const int* in_sizes, int n_in, void* d_out, int out_size, void* d_ws, size_t ws_size, hipStream_t stream) {
    static int grid = 0;
    if (grid == 0) {
        if (n_in != 26 || ws_size < WS_END) { fprintf(stderr, "kernel_launch: expected 26 inputs and >= %zu bytes of workspace (got %d, %zu)\n", (size_t)WS_END, n_in, ws_size); grid = -1; return; }
        int dev = 0, cus = 0, per_cu = 0;
        hipGetDevice(&dev); hipDeviceGetAttribute(&cus, hipDeviceAttributeMultiprocessorCount, dev);
        if (hipFuncSetAttribute((const void*)fwd_kernel, hipFuncAttributeMaxDynamicSharedMemorySize, LDS_BYTES) != hipSuccess) { fprintf(stderr, "kernel_launch: hipFuncSetAttribute failed\n"); grid = -1; return; }
        hipOccupancyMaxActiveBlocksPerMultiprocessor(&per_cu, (const void*)fwd_kernel, 512, LDS_BYTES);
        if (per_cu < 1) { fprintf(stderr, "kernel_launch: occupancy query says %d blocks per CU\n", per_cu); per_cu = 1; }
        (void)hipGetLastError();
        grid = cus;
    }
    if (grid < 0) return;
    if (hipMemsetAsync((char*)d_ws + WS_BAR, 0, 16384, stream) != hipSuccess) { fprintf(stderr, "kernel_launch: memset failed\n"); return; }
    Args a{};
    const float** p = (const float**)&a;
    for (int i = 0; i < 26; ++i) p[i] = (const float*)d_in[i];
    a.out = (float*)d_out; a.ws = (unsigned char*)d_ws;
#if MK_SPLIT
    for (int ph = 0; ph < NPHASE; ++ph) { a.ph_lo = ph; a.ph_hi = ph + 1; hipLaunchKernelGGL(fwd_kernel, dim3(grid), dim3(512), LDS_BYTES, stream, a); }
#else
    a.ph_lo = 0; a.ph_hi = NPHASE;
    void* args[] = {&a};
    hipError_t e = hipLaunchCooperativeKernel((const void*)fwd_kernel, dim3(grid), dim3(512), args, LDS_BYTES, stream);
    if (e != hipSuccess) fprintf(stderr, "cooperative launch failed: %s (grid %d)\n", hipGetErrorString(e), grid);
#endif
}
```
